# Optimizing an MI355X kernel written in HIP

```python
import math
import jax, jax.numpy as jnp
from jax import lax
import numpy as np

D_MODEL = 1024
BATCH = 8
SEQ = 4096
DEPTH = 4

CHUNK = 64
QBLK = 128
PLE_DIM = 256
N_BUCKETS = 32
MAX_DISTANCE = 256
ROPE_THETA = 10000.0
LN_EPS = 1e-5
RMS_EPS = 1e-6

H_A = 8
A_NOPE = 64
A_ROPE = 32
A_V = 64
A_Q_RANK = 512
A_KV_RANK = 256
A_SCALE = (A_NOPE + A_ROPE) ** -0.5
H_B = 8
B_DH = 32
B_SCALE = B_DH ** -0.5
H_C = 16
KV_C = 4
C_GROUP = H_C // KV_C
C_DH = 64
C_SCALE = C_DH ** -0.5
H_IDX = 16
IDX_DH = 64
IDX_ROPE = 32
IDX_SCALE = IDX_DH ** -0.5
TOPK_MAX = 256
P_HEADS = 8
N_KEYS = 128
N_EXPERTS = N_KEYS * N_KEYS
P_DQ = 256
P_DHALF = P_DQ // 2
P_TOPK = 16
P_BLK = 128

EVEN_MIX = H_A * A_V + H_B * 2 * B_DH
ODD_MIX = H_C * C_DH
EVEN_SPLITS = (A_Q_RANK, A_KV_RANK, A_ROPE, H_B * 2 * B_DH, H_B * 2 * B_DH, H_B * 2 * B_DH)
ODD_SPLITS = (H_C * C_DH, KV_C * C_DH, KV_C * C_DH, H_IDX * IDX_DH, IDX_DH, H_IDX)
N_EVEN = (DEPTH + 1) // 2
N_ODD = DEPTH // 2
DN_ALPHA = (2 * DEPTH) ** 0.25
DN_BETA = (8 * DEPTH) ** -0.25

kernel_name = 'hybrid_mla_diff_dsa_peer_encoder'


def split_cols(a, sizes):
    out, start = [], 0
    for s in sizes:
        out.append(a[..., start:start + s])
        start += s
    return out


def layer_norm(x, g, b):
    xf = x.astype(jnp.float32)
    mu = jnp.mean(xf, axis=-1, keepdims=True)
    xc = xf - mu
    var = jnp.mean(xc * xc, axis=-1, keepdims=True)
    return (xc * lax.rsqrt(var + LN_EPS) * g.astype(jnp.float32) + b.astype(jnp.float32)).astype(x.dtype)


def rms_norm(x, g):
    xf = x.astype(jnp.float32)
    y = xf * lax.rsqrt(jnp.mean(xf * xf, axis=-1, keepdims=True) + RMS_EPS)
    return (y * g.astype(jnp.float32)).astype(x.dtype)


def rope(x, pos):
    half = x.shape[-1] // 2
    freqs = ROPE_THETA ** (-jnp.arange(half, dtype=jnp.float32) / half)
    ang = pos.astype(jnp.float32)[..., None] * freqs
    ang = ang.reshape(ang.shape[:2] + (1,) * (x.ndim - 3) + (half,))
    cos, sin = jnp.cos(ang), jnp.sin(ang)
    x1 = x[..., :half].astype(jnp.float32)
    x2 = x[..., half:].astype(jnp.float32)
    return jnp.concatenate([x1 * cos - x2 * sin, x2 * cos + x1 * sin], axis=-1).astype(x.dtype)


def rope_partial(x, pos):
    return jnp.concatenate([rope(x[..., :IDX_ROPE], pos), x[..., IDX_ROPE:]], axis=-1)


def t5_bucket(rel):
    nb = N_BUCKETS // 2
    max_exact = nb // 2
    n = jnp.abs(rel)
    large = max_exact + (jnp.log(jnp.maximum(n, 1).astype(jnp.float32) / max_exact)
                         / math.log(MAX_DISTANCE / max_exact) * (nb - max_exact)).astype(jnp.int32)
    large = jnp.minimum(large, nb - 1)
    return jnp.where(rel > 0, nb, 0) + jnp.where(n < max_exact, n, large)


def to_blocks(a):
    b, s = a.shape[:2]
    return jnp.moveaxis(a.reshape((b, s // QBLK, QBLK) + a.shape[2:]), 1, 0)


def from_blocks(a):
    a = jnp.moveaxis(a, 0, 1)
    return a.reshape((a.shape[0], a.shape[1] * a.shape[2]) + a.shape[3:])


def even_mixer(h, positions, w_in, w_uq, w_ukv, q_norm_g, kv_norm_g,
               lam_q1, lam_k1, lam_q2, lam_k2, subln_g, w_o, bias_tab, lam_init):
    b, s, _ = h.shape
    c_q, c_kv, k_r, q_d, k_d, v_d = split_cols(h @ w_in, EVEN_SPLITS)
    q_a = (rms_norm(c_q, q_norm_g) @ w_uq).reshape(b, s, H_A, A_NOPE + A_ROPE)
    q_nope, q_rope = q_a[..., :A_NOPE], rope(q_a[..., A_NOPE:], positions)
    kv_a = (rms_norm(c_kv, kv_norm_g) @ w_ukv).reshape(b, s, H_A, A_NOPE + A_V)
    k_nope, v_a = kv_a[..., :A_NOPE], kv_a[..., A_NOPE:]
    k_rope = rope(k_r, positions)
    q_d = q_d.reshape(b, s, H_B, 2, B_DH)
    k_d = k_d.reshape(b, s, H_B, 2, B_DH)
    v_d = v_d.reshape(b, s, H_B, 2 * B_DH)
    lam = (jnp.exp(jnp.sum(lam_q1 * lam_k1, dtype=jnp.float32))
           - jnp.exp(jnp.sum(lam_q2 * lam_k2, dtype=jnp.float32)) + lam_init)
    key_chunk = jnp.arange(s) // CHUNK

    def block(args):
        qn, qr, qd, qpos, bi = args
        q_chunk = (bi * QBLK + jnp.arange(QBLK)) // CHUNK
        allowed = key_chunk[None, :] <= q_chunk[:, None]
        s_a = (jnp.einsum('bqhd,bkhd->bhqk', qn, k_nope)
               + jnp.einsum('bqhr,bkr->bhqk', qr, k_rope)) * A_SCALE
        p_a = jax.nn.softmax(jnp.where(allowed, s_a.astype(jnp.float32), -jnp.inf), axis=-1)
        o_a = jnp.einsum('bhqk,bkhd->bqhd', p_a.astype(v_a.dtype), v_a)
        bucket = t5_bucket(positions[:, None, :] - qpos[:, :, None])
        bias = jnp.moveaxis(bias_tab[bucket], -1, 1).astype(jnp.float32)
        s_d = jnp.einsum('bqhmd,bkhmd->bhmqk', qd, k_d).astype(jnp.float32) * B_SCALE + bias[:, :, None]
        p_d = jax.nn.softmax(jnp.where(allowed, s_d, -jnp.inf), axis=-1)
        w_d = p_d[:, :, 0] - lam * p_d[:, :, 1]
        o_d = jnp.einsum('bhqk,bkhd->bqhd', w_d.astype(v_d.dtype), v_d)
        o_d = rms_norm(o_d, subln_g) * (1.0 - lam_init)
        return jnp.concatenate([o_a.reshape(b, QBLK, H_A * A_V),
                                o_d.reshape(b, QBLK, H_B * 2 * B_DH)], axis=-1)

    nb = s // QBLK
    o = lax.map(block, (to_blocks(q_nope), to_blocks(q_rope), to_blocks(q_d),
                        to_blocks(positions), jnp.arange(nb)))
    return from_blocks(o) @ w_o


def odd_mixer(h, positions, w_in, w_o, bias_tab):
    b, s, _ = h.shape
    q, k, v, qi, ki, wi = split_cols(h @ w_in, ODD_SPLITS)
    q = q.reshape(b, s, KV_C, C_GROUP, C_DH)
    k = k.reshape(b, s, KV_C, C_DH)
    v = v.reshape(b, s, KV_C, C_DH)
    qi = rope_partial(qi.reshape(b, s, H_IDX, IDX_DH), positions)
    ki = rope_partial(ki, positions)
    wi = wi * (H_IDX ** -0.5)
    n_sel = min(TOPK_MAX, s // 4)
    key_chunk = jnp.arange(s) // CHUNK
    gather = jax.vmap(lambda a, idx: a[idx])

    def block(args):
        qb, qib, wib, qpos, bi = args
        q_chunk = (bi * QBLK + jnp.arange(QBLK)) // CHUNK
        allowed = key_chunk[None, :] <= q_chunk[:, None]
        idx_logits = jnp.einsum('bqhd,bkd->bqhk', qib, ki) * IDX_SCALE
        score = jnp.einsum('bqh,bqhk->bqk', wib, jax.nn.relu(idx_logits)).astype(jnp.float32)
        top_s, sel = lax.top_k(jnp.where(allowed, score, -jnp.inf), n_sel)
        valid = jnp.isfinite(top_s)
        kg = gather(k, sel)
        vg = gather(v, sel)
        rel = gather(positions, sel) - qpos[:, :, None]
        bias = bias_tab[t5_bucket(rel)].reshape(b, QBLK, n_sel, KV_C, C_GROUP)
        bias = jnp.transpose(bias, (0, 1, 3, 4, 2)).astype(jnp.float32)
        sc = jnp.einsum('bqkgd,bqnkd->bqkgn', qb, kg).astype(jnp.float32) * C_SCALE + bias
        pr = jax.nn.softmax(jnp.where(valid[:, :, None, None, :], sc, -jnp.inf), axis=-1)
        o = jnp.einsum('bqkgn,bqnkd->bqkgd', pr.astype(vg.dtype), vg)
        return o.reshape(b, QBLK, H_C * C_DH)

    nb = s // QBLK
    o = lax.map(block, (to_blocks(q), to_blocks(qi), to_blocks(wi),
                        to_blocks(positions), jnp.arange(nb)))
    return from_blocks(o) @ w_o


def peer(h, w_q, sub_k1, sub_k2, u_tab, v_tab):
    b, s, d = h.shape
    t = b * s
    xt = h.reshape(t, d)
    q = (xt @ w_q).reshape(t, P_HEADS, 2, P_DHALF)
    s1 = jnp.einsum('thd,nd->thn', q[:, :, 0], sub_k1).astype(jnp.float32)
    s2 = jnp.einsum('thd,nd->thn', q[:, :, 1], sub_k2).astype(jnp.float32)
    t1, i1 = lax.top_k(s1, P_TOPK)
    t2, i2 = lax.top_k(s2, P_TOPK)
    cand = (t1[..., :, None] + t2[..., None, :]).reshape(t, P_HEADS, P_TOPK * P_TOPK)
    cidx = (i1[..., :, None] * N_KEYS + i2[..., None, :]).reshape(t, P_HEADS, P_TOPK * P_TOPK)
    top_s, pick = lax.top_k(cand, P_TOPK)
    eidx = jnp.take_along_axis(cidx, pick, axis=-1).reshape(t, P_HEADS * P_TOPK)
    g = jax.nn.softmax(top_s, axis=-1).reshape(t, P_HEADS * P_TOPK).astype(h.dtype)
    nb = t // P_BLK

    def expert_block(args):
        xb, eb, gb = args
        hb = jnp.einsum('tkd,td->tk', u_tab[eb], xb)
        return jnp.einsum('tk,tkd->td', gb * jax.nn.gelu(hb), v_tab[eb])

    out = lax.map(expert_block, (xt.reshape(nb, P_BLK, d),
                                 eidx.reshape(nb, P_BLK, P_HEADS * P_TOPK),
                                 g.reshape(nb, P_BLK, P_HEADS * P_TOPK)))
    return out.reshape(b, s, d)


def setup_inputs(seed: int = 0) -> dict:
    key = jax.random.key(seed)
    ks = iter(jax.random.split(key, 32))

    def nrm(shape, scale):
        return jax.random.normal(next(ks), shape, jnp.float32) * scale

    offs = jax.random.randint(next(ks), (BATCH,), 0, 64, dtype=jnp.int32) * CHUNK
    positions = offs[:, None] + jnp.arange(SEQ, dtype=jnp.int32)[None, :]
    ev_in = sum(EVEN_SPLITS)
    od_in = sum(ODD_SPLITS)
    return {
        'x': nrm((BATCH, SEQ, D_MODEL), 1.0),
        'p': nrm((DEPTH, BATCH, SEQ, PLE_DIM), 1.0),
        'positions': positions,
        'rel_bias': nrm((N_BUCKETS, H_B + H_C), 0.2),
        'ev_w_in': nrm((N_EVEN, D_MODEL, ev_in), D_MODEL ** -0.5),
        'ev_w_uq': nrm((N_EVEN, A_Q_RANK, H_A * (A_NOPE + A_ROPE)), A_Q_RANK ** -0.5),
        'ev_w_ukv': nrm((N_EVEN, A_KV_RANK, H_A * (A_NOPE + A_V)), A_KV_RANK ** -0.5),
        'ev_q_norm': 1.0 + nrm((N_EVEN, A_Q_RANK), 0.02),
        'ev_kv_norm': 1.0 + nrm((N_EVEN, A_KV_RANK), 0.02),
        'ev_lam_q1': nrm((N_EVEN, B_DH), 0.1),
        'ev_lam_k1': nrm((N_EVEN, B_DH), 0.1),
        'ev_lam_q2': nrm((N_EVEN, B_DH), 0.1),
        'ev_lam_k2': nrm((N_EVEN, B_DH), 0.1),
        'ev_subln': 1.0 + nrm((N_EVEN, 2 * B_DH), 0.02),
        'ev_w_o': nrm((N_EVEN, EVEN_MIX, D_MODEL), DN_BETA * EVEN_MIX ** -0.5),
        'od_w_in': nrm((N_ODD, D_MODEL, od_in), D_MODEL ** -0.5),
        'od_w_o': nrm((N_ODD, ODD_MIX, D_MODEL), DN_BETA * ODD_MIX ** -0.5),
        'ln1_g': 1.0 + nrm((DEPTH, D_MODEL), 0.02),
        'ln1_b': nrm((DEPTH, D_MODEL), 0.02),
        'ln2_g': 1.0 + nrm((DEPTH, D_MODEL), 0.02),
        'ln2_b': nrm((DEPTH, D_MODEL), 0.02),
        'peer_w_q': nrm((DEPTH, D_MODEL, P_HEADS * P_DQ), D_MODEL ** -0.5),
        'peer_k1': nrm((DEPTH, N_KEYS, P_DHALF), P_DHALF ** -0.5),
        'peer_k2': nrm((DEPTH, N_KEYS, P_DHALF), P_DHALF ** -0.5),
        'peer_u': nrm((DEPTH, N_EXPERTS, D_MODEL), D_MODEL ** -0.5),
        'peer_v': nrm((DEPTH, N_EXPERTS, D_MODEL), DN_BETA * P_HEADS ** -0.5),
        'ple_w': nrm((DEPTH, PLE_DIM, D_MODEL), DN_BETA * PLE_DIM ** -0.5),
        'ple_gate_w': nrm((DEPTH, D_MODEL, D_MODEL), D_MODEL ** -0.5),
        'ple_gate_b': nrm((DEPTH, D_MODEL), 0.02),
    }


def reference(x, p, positions, rel_bias, ev_w_in, ev_w_uq, ev_w_ukv, ev_q_norm, ev_kv_norm,
              ev_lam_q1, ev_lam_k1, ev_lam_q2, ev_lam_k2, ev_subln, ev_w_o, od_w_in, od_w_o,
              ln1_g, ln1_b, ln2_g, ln2_b, peer_w_q, peer_k1, peer_k2, peer_u, peer_v,
              ple_w, ple_gate_w, ple_gate_b):
    bias_b = rel_bias[:, :H_B]
    bias_c = rel_bias[:, H_B:]
    h = x
    for i in range(DEPTH):
        j = i // 2
        if i % 2 == 0:
            lam_init = 0.8 - 0.6 * math.exp(-0.3 * i)
            mix = even_mixer(h, positions, ev_w_in[j], ev_w_uq[j], ev_w_ukv[j], ev_q_norm[j],
                             ev_kv_norm[j], ev_lam_q1[j], ev_lam_k1[j], ev_lam_q2[j], ev_lam_k2[j],
                             ev_subln[j], ev_w_o[j], bias_b, lam_init)
        else:
            mix = odd_mixer(h, positions, od_w_in[j], od_w_o[j], bias_c)
        h = layer_norm(DN_ALPHA * h + mix, ln1_g[i], ln1_b[i])
        ffn = peer(h, peer_w_q[i], peer_k1[i], peer_k2[i], peer_u[i], peer_v[i])
        h = layer_norm(DN_ALPHA * h + ffn, ln2_g[i], ln2_b[i])
        gate = jax.nn.sigmoid(h @ ple_gate_w[i] + ple_gate_b[i])
        h = h + gate * (p[i] @ ple_w[i])
    return h
```

```cpp
#include <hip/hip_runtime.h>
#include <hip/hip_cooperative_groups.h>
#include <stdint.h>
#include <cstdio>
namespace cg = cooperative_groups;

#ifndef MULTI_LAUNCH
#define MULTI_LAUNCH 0
#endif

typedef unsigned short bf16_t;
typedef __attribute__((ext_vector_type(8))) short bf16x8;
typedef __attribute__((ext_vector_type(16))) float f32x16;
typedef __attribute__((ext_vector_type(4))) float f32x4;
typedef __attribute__((ext_vector_type(2))) float f32x2;
typedef __attribute__((ext_vector_type(4))) unsigned u32x4;
typedef __attribute__((ext_vector_type(2))) unsigned u32x2;
typedef __attribute__((ext_vector_type(2))) __bf16 bf16x2v;

#define DI __device__ __forceinline__

constexpr int T_ = 32768, S_ = 4096;
constexpr float DN_ALPHA = 1.6817928305074290f;
constexpr float L2E = 1.4426950408889634f;
constexpr int NE = 2432;
constexpr int NO = 2688;

constexpr size_t MiB = 1024ull * 1024ull;
constexpr size_t OFF_TABU = 0, OFF_TABV = 32 * MiB, OFF_W = 64 * MiB, OFF_H = 128 * MiB, OFF_HBA = 256 * MiB,
                 OFF_HBB = 320 * MiB, OFF_RA = 384 * MiB, OFF_RB = 576 * MiB, OFF_RO = 736 * MiB, OFF_OD = 800 * MiB,
                 OFF_PK = 928 * MiB, OFF_MISC = 960 * MiB;
constexpr size_t RB_QA = 0, RB_KN = 48 * MiB, RB_VTA = 80 * MiB, RB_VTD = 112 * MiB;
constexpr size_t MS_CS = 0  , MS_LUTB = 4 * MiB  , MS_LUTC = 4 * MiB + 32768  ,
                 MS_PMM = 4 * MiB + 98304  , MS_LAM = 4 * MiB + 110592, MS_RSQ = 5 * MiB, MS_RSKV = 5 * MiB + 131072 * 2;
constexpr size_t WE_IN = 0, WE_UQ = 2490368, WE_UKV = WE_UQ + 393216, WE_O = WE_UKV + 262144, WE_SZ = 4194304;
constexpr size_t WO_BASE = 2 * WE_SZ, WO_IN = 0, WO_O = 2752512, WO_SZ = 3801088;
constexpr size_t WL_BASE = WO_BASE + 2 * WO_SZ, WL_Q = 0, WL_K1 = 2097152, WL_K2 = WL_K1 + 16384, WL_G = WL_K2 + 16384,
                 WL_PLE = WL_G + 1048576, WL_SZ = 3440640;

struct Params {
  const float *x, *p; const int* pos; const float* rel_bias;
  const float *ev_w_in, *ev_w_uq, *ev_w_ukv, *ev_q_norm, *ev_kv_norm, *lq1, *lk1, *lq2, *lk2, *ev_subln, *ev_w_o;
  const float *od_w_in, *od_w_o, *ln1_g, *ln1_b, *ln2_g, *ln2_b, *peer_w_q, *peer_k1, *peer_k2, *peer_u, *peer_v,
      *ple_w, *ple_gate_w, *ple_gate_b;
  float* out; char* ws; int ph0, ph1;
};

DI unsigned pack_bf16(float a, float b) {
  f32x2 v = {a, b};
  bf16x2v r = __builtin_convertvector(v, bf16x2v);
  return __builtin_bit_cast(unsigned, r);
}
DI bf16_t f2bf(float a) { return (bf16_t)(pack_bf16(a, 0.f) & 0xffffu); }
DI float bf_lo(unsigned u) { return __uint_as_float(u << 16); }
DI float bf_hi(unsigned u) { return __uint_as_float(u & 0xffff0000u); }
DI float bf2f(bf16_t x) { return __uint_as_float(((unsigned)x) << 16); }
DI float dot2(unsigned a, unsigned b, float c) {
  return __builtin_amdgcn_fdot2_f32_bf16(__builtin_bit_cast(bf16x2v, a), __builtin_bit_cast(bf16x2v, b), c, false);
}
DI float wave_sum(float v) {
#pragma unroll
  for (int o = 32; o >= 1; o >>= 1) v += __shfl_xor(v, o);
  return v;
}
DI float wave_max(float v) {
#pragma unroll
  for (int o = 32; o >= 1; o >>= 1) v = fmaxf(v, __shfl_xor(v, o));
  return v;
}
DI float row16_sum(float x) {
  x += __builtin_bit_cast(float, __builtin_amdgcn_update_dpp(0, __builtin_bit_cast(int, x), 0xB1, 0xf, 0xf, true));
  x += __builtin_bit_cast(float, __builtin_amdgcn_update_dpp(0, __builtin_bit_cast(int, x), 0x4E, 0xf, 0xf, true));
  x += __builtin_bit_cast(float, __builtin_amdgcn_update_dpp(0, __builtin_bit_cast(int, x), 0x141, 0xf, 0xf, true));
  x += __builtin_bit_cast(float, __builtin_amdgcn_update_dpp(0, __builtin_bit_cast(int, x), 0x140, 0xf, 0xf, true));
  return x;
}
DI f32x16 mfma32(bf16x8 a, bf16x8 b, f32x16 c) { return __builtin_amdgcn_mfma_f32_32x32x16_bf16(a, b, c, 0, 0, 0); }
DI f32x4 mfma16(bf16x8 a, bf16x8 b, f32x4 c) { return __builtin_amdgcn_mfma_f32_16x16x32_bf16(a, b, c, 0, 0, 0); }
DI int crow(int i, int h) { return (i & 3) + 8 * (i >> 2) + 4 * h; }

template <int WM, bool SYNC_EPI = false, int EXP = 0, class Epi>
DI void gemm_tile(const bf16_t* __restrict__ A, int lda, const bf16_t* __restrict__ Bt, int K, int m0, int n0,
                  char* lds, Epi& epi) {
  int tid_ = threadIdx.x; asm volatile("" : "+v"(tid_));
  const int tid = tid_, lane = tid & 63, w = tid >> 6, wm = w >> 1, wn = w & 1, hh = lane >> 5, l31 = lane & 31;
  constexpr int BM = 64 * WM;
  constexpr int NA = BM / 32;
  bf16_t* As = (bf16_t*)lds;
  bf16_t* Bs = As + BM * 72;
  f32x16 acc[WM][2];
#pragma unroll
  for (int a = 0; a < WM; ++a)
#pragma unroll
    for (int b = 0; b < 2; ++b)
#pragma unroll
      for (int i = 0; i < 16; ++i) acc[a][b][i] = 0.f;
  const int nk = K >> 6;
  u32x4 ra[NA], rb[4];
  const int prow = tid >> 3, pc = (tid & 7) * 8;
  const bf16_t* ag = A + (size_t)(m0 + prow) * lda + pc;
  const bf16_t* bg = Bt + (size_t)(n0 + prow) * K + pc;
  auto gload = [&](int kt) {
#pragma unroll
    for (int i = 0; i < NA; ++i) ra[i] = *(const u32x4*)(ag + (size_t)(32 * i) * lda + kt * 64);
#pragma unroll
    for (int i = 0; i < 4; ++i) rb[i] = *(const u32x4*)(bg + (size_t)(32 * i) * K + kt * 64);
  };
  auto lstore = [&]() {
#pragma unroll
    for (int i = 0; i < NA; ++i) *(u32x4*)(As + (prow + 32 * i) * 72 + pc) = ra[i];
#pragma unroll
    for (int i = 0; i < 4; ++i) *(u32x4*)(Bs + (prow + 32 * i) * 72 + pc) = rb[i];
  };
  gload(0);
  for (int kt = 0; kt < nk; ++kt) {
    if (EXP != 5) __syncthreads();
    if (EXP != 3 || kt == 0) lstore();
    if (EXP != 5) __syncthreads();
    if (EXP != 2 && EXP != 3) { if (kt + 1 < nk) gload(kt + 1); }
#pragma unroll
    for (int s = 0; s < 4; ++s) {
      if (EXP == 4) break;
      bf16x8 af[WM], bfr[2];
#pragma unroll
      for (int mt = 0; mt < WM; ++mt)
        af[mt] = *(const bf16x8*)(As + (32 * WM * wm + 32 * mt + l31) * 72 + s * 16 + hh * 8);
#pragma unroll
      for (int nt = 0; nt < 2; ++nt)
        bfr[nt] = *(const bf16x8*)(Bs + (64 * wn + 32 * nt + l31) * 72 + s * 16 + hh * 8);
#pragma unroll
      for (int mt = 0; mt < WM; ++mt)
#pragma unroll
        for (int nt = 0; nt < 2; ++nt) acc[mt][nt] = mfma32(af[mt], bfr[nt], acc[mt][nt]);
    }
  }
  if (SYNC_EPI) __syncthreads();
  if (EXP == 1) { if (acc[0][0][0] != 12345.678f) return; }
#pragma unroll
  for (int mt = 0; mt < WM; ++mt)
#pragma unroll
    for (int nt = 0; nt < 2; ++nt) epi(m0 + 32 * WM * wm + 32 * mt, n0 + 64 * wn + 32 * nt, acc[mt][nt], lane);
}

DI void store_vT(bf16_t* vT, int head, int dim, int r, float v0, float v1, float v2, float v3) {
  int b = r >> 12, s = r & 4095;
  u32x2 pk = {pack_bf16(v0, v1), pack_bf16(v2, v3)};
  *(u32x2*)(vT + ((size_t)((b * 8 + head) * 64 + dim)) * S_ + s) = pk;
}

struct EpiEvenProj {
  bf16_t* proj; bf16_t* vTd;
  DI void operator()(int rb, int cb, const f32x16& a, int lane) const {
    int c = cb + (lane & 31), h = lane >> 5;
    if (cb < 1824) {
#pragma unroll
      for (int i = 0; i < 16; ++i) proj[(size_t)(rb + crow(i, h)) * NE + c] = f2bf(a[i]);
    } else if (cb < 2336) {
      int cc = c - 1824, head = cc >> 6, dim = cc & 63;
#pragma unroll
      for (int g = 0; g < 4; ++g) store_vT(vTd, head, dim, rb + 8 * g + 4 * h, a[4 * g], a[4 * g + 1], a[4 * g + 2], a[4 * g + 3]);
    }
  }
};
struct EpiRowScaleBf16 {
  bf16_t* out; int ldo; const float* rs;
  DI void operator()(int rb, int cb, const f32x16& a, int lane) const {
    int c = cb + (lane & 31), h = lane >> 5;
#pragma unroll
    for (int i = 0; i < 16; ++i) { int r = rb + crow(i, h); out[(size_t)r * ldo + c] = f2bf(a[i] * rs[r]); }
  }
};
struct EpiKV {
  bf16_t* kn; bf16_t* vTa; const float* rs;
  DI void operator()(int rb, int cb, const f32x16& a, int lane) const {
    int c = cb + (lane & 31), h = lane >> 5, head = c >> 7, d = c & 127;
    if (d < 64) {
#pragma unroll
      for (int i = 0; i < 16; ++i) { int r = rb + crow(i, h); kn[(size_t)r * 512 + head * 64 + d] = f2bf(a[i] * rs[r]); }
    } else {
#pragma unroll
      for (int g = 0; g < 4; ++g) {
        int r = rb + 8 * g + 4 * h;
        store_vT(vTa, head, d - 64, r, a[4 * g] * rs[r], a[4 * g + 1] * rs[r + 1], a[4 * g + 2] * rs[r + 2], a[4 * g + 3] * rs[r + 3]);
      }
    }
  }
};
struct EpiBf16 {
  bf16_t* out; int ldo; int nvalid;
  DI void operator()(int rb, int cb, const f32x16& a, int lane) const {
    int c = cb + (lane & 31), h = lane >> 5;
    if (cb < nvalid) {
#pragma unroll
      for (int i = 0; i < 16; ++i) out[(size_t)(rb + crow(i, h)) * ldo + c] = f2bf(a[i]);
    }
  }
};
struct EpiResid {
  bf16_t* y; const float* hres; const bf16_t* hresb;
  DI void operator()(int rb, int cb, const f32x16& a, int lane) const {
    int c = cb + (lane & 31), h = lane >> 5;
    if (hres) {
#pragma unroll
      for (int i = 0; i < 16; ++i) { size_t o = (size_t)(rb + crow(i, h)) * 1024 + c; y[o] = f2bf(DN_ALPHA * hres[o] + a[i]); }
    } else {
#pragma unroll
      for (int i = 0; i < 16; ++i) { size_t o = (size_t)(rb + crow(i, h)) * 1024 + c; y[o] = f2bf(DN_ALPHA * bf2f(hresb[o]) + a[i]); }
    }
  }
};
struct EpiGate {
  const bf16_t* hin; float* outp; bf16_t* hb; const bf16_t* pw; const float* bg;
  DI void operator()(int rb, int cb, const f32x16& a, int lane) const {
    int c = cb + (lane & 31), h = lane >> 5;
    float bb = bg[c];
#pragma unroll
    for (int i = 0; i < 16; ++i) {
      size_t o = (size_t)(rb + crow(i, h)) * 1024 + c;
      float g = 1.f / (1.f + __expf(-(a[i] + bb)));
      float hn = bf2f(hin[o]) + g * bf2f(pw[o]);
      if (outp) outp[o] = hn;
      hb[o] = f2bf(hn);
    }
  }
};
struct EpiLds {
  float* s;
  DI void operator()(int rb, int cb, const f32x16& a, int lane) const {
    int c = (cb & 127) + (lane & 31), h = lane >> 5;
#pragma unroll
    for (int i = 0; i < 16; ++i) { int r = (rb & 127) + crow(i, h); s[r * 128 + ((c + r) & 127)] = a[i]; }
  }
};

DI void conv_item(const float* __restrict__ src, bf16_t* __restrict__ dst, int item) {
  int tid_ = threadIdx.x; asm volatile("" : "+v"(tid_));
  size_t o = (size_t)item * 2048 + tid_ * 8;
  f32x4 v0 = *(const f32x4*)(src + o), v1 = *(const f32x4*)(src + o + 4);
  u32x4 r = {pack_bf16(v0[0], v0[1]), pack_bf16(v0[2], v0[3]), pack_bf16(v1[0], v1[1]), pack_bf16(v1[2], v1[3])};
  *(u32x4*)(dst + o) = r;
}
DI void convfp8_item(const float* __restrict__ src, unsigned char* __restrict__ dst, float* __restrict__ inv_scale, int item) {
  int tid_ = threadIdx.x; asm volatile("" : "+v"(tid_));
  const int lane = tid_ & 63, row = item * 4 + (tid_ >> 6);
  const float* r = src + (size_t)row * 1024 + 16 * lane;
  f32x4 v[4];
  float am = 0.f;
#pragma unroll
  for (int k = 0; k < 4; ++k) {
    v[k] = *(const f32x4*)(r + 4 * k);
    am = fmaxf(am, fmaxf(fmaxf(fabsf(v[k][0]), fabsf(v[k][1])), fmaxf(fabsf(v[k][2]), fabsf(v[k][3]))));
  }
  am = wave_max(am);
  const float sc = am > 0.f ? 224.f / am : 1.f;
  u32x4 o;
#pragma unroll
  for (int k = 0; k < 4; ++k) {
    int p = 0;
    p = __builtin_amdgcn_cvt_pk_fp8_f32(v[k][0] * sc, v[k][1] * sc, p, false);
    p = __builtin_amdgcn_cvt_pk_fp8_f32(v[k][2] * sc, v[k][3] * sc, p, true);
    o[k] = (unsigned)p;
  }
  *(u32x4*)(dst + (size_t)row * 1024 + 16 * lane) = o;
  if (lane == 0) inv_scale[row] = 1.f / sc;
}
DI void tconv_item(const float* __restrict__ src, int K, int N, int Npad, bf16_t* __restrict__ dst,
                   const float* __restrict__ g, int item, char* lds) {
  float* tile = (float*)lds;
  int tid_ = threadIdx.x; asm volatile("" : "+v"(tid_));
  const int tid = tid_;
  const int tn = Npad >> 6;
  const int k0 = (item / tn) * 64, n0 = (item % tn) * 64;
#pragma unroll
  for (int i = 0; i < 4; ++i) {
    int r = (tid >> 4) + 16 * i, c4 = (tid & 15) * 4;
    f32x4 v = {0.f, 0.f, 0.f, 0.f};
    if (n0 + c4 < N) v = *(const f32x4*)(src + (size_t)(k0 + r) * N + n0 + c4);
    float sc = g ? g[k0 + r] : 1.f;
#pragma unroll
    for (int e = 0; e < 4; ++e) tile[r * 65 + c4 + e] = v[e] * sc;
  }
  __syncthreads();
  {
    int nl = tid >> 2, kp = (tid & 3) * 16;
    unsigned pk[8];
#pragma unroll
    for (int e = 0; e < 8; ++e) pk[e] = pack_bf16(tile[(kp + 2 * e) * 65 + nl], tile[(kp + 2 * e + 1) * 65 + nl]);
    bf16_t* d = dst + (size_t)(n0 + nl) * K + k0 + kp;
    u32x4 a = {pk[0], pk[1], pk[2], pk[3]}, b = {pk[4], pk[5], pk[6], pk[7]};
    *(u32x4*)d = a;
    *(u32x4*)(d + 8) = b;
  }
  __syncthreads();
}

DI int t5_bucket(int rel) {
  int n = rel < 0 ? -rel : rel;
  float fn = (float)(n > 1 ? n : 1);
  int large = 8 + (int)(logf(fn / 8.f) / 3.4657359027997265f * 8.f);
  large = large < 15 ? large : 15;
  return (rel > 0 ? 16 : 0) + (n < 8 ? n : large);
}

template <int DQK, bool BIAS>
DI void attn_item(const bf16_t* __restrict__ Qp, int qs, const bf16_t* __restrict__ K1p, int k1s,
                  const bf16_t* __restrict__ K2p, int k2s, const bf16_t* __restrict__ vT, const int* __restrict__ posb,
                  const float* __restrict__ lut, const int* __restrict__ pmm, int tok0  , int qt, float scale_l2e,
                  char* lds, bf16_t* ob, float* of, int ostride) {
  constexpr int KST = DQK + 8;
  constexpr int NPC = DQK / 8;
  constexpr int NP = DQK / 32;
  constexpr int NS = DQK / 16;
  int tid_ = threadIdx.x; asm volatile("" : "+v"(tid_));
  const int tid = tid_, lane = tid & 63, w = tid >> 6, hh = lane >> 5, l31 = lane & 31;
  bf16_t* Ks = (bf16_t*)lds;
  bf16_t* Vs = (bf16_t*)(lds + 13312);
  int* posk = (int*)(lds + 22016);
  float* lut_s = (float*)(lds + 22272);
  const int qrow = 128 * qt + 32 * w + l31;
  const int ntile = 2 * qt + 2;
  const int mylast = 2 * qt + (w >> 1);
  bf16x8 qf[NS];
#pragma unroll
  for (int s = 0; s < NS; ++s) qf[s] = *(const bf16x8*)(Qp + (size_t)(tok0 + qrow) * qs + 16 * s + 8 * hh);
  int posq = 0, qmin = 0;
  if (BIAS) {
    posq = posb[qrow];
    qmin = posq;
#pragma unroll
    for (int o = 16; o >= 1; o >>= 1) { int t = __shfl_xor(qmin, o); qmin = t < qmin ? t : qmin; }
    __syncthreads();
    for (int i = tid; i < 513; i += 256) lut_s[i] = lut[i];
  }
  f32x16 oacc[2];
#pragma unroll
  for (int i = 0; i < 16; ++i) { oacc[0][i] = 0.f; oacc[1][i] = 0.f; }
  float mrun = -INFINITY, lrun = 0.f;
  u32x4 kr[NP], vr[2]; int pr = 0;
  auto gload = [&](int kt) {
    const int key0 = kt * 64;
#pragma unroll
    for (int i = 0; i < NP; ++i) {
      int p = tid + 256 * i, row = p / NPC, c = p % NPC;
      const bf16_t* src = (DQK == 32 || c < 8) ? K1p + (size_t)(tok0 + key0 + row) * k1s + 8 * c
                                                : K2p + (size_t)(tok0 + key0 + row) * k2s + 8 * (c - 8);
      kr[i] = *(const u32x4*)src;
    }
#pragma unroll
    for (int i = 0; i < 2; ++i) {
      int p = tid + 256 * i, d = p >> 3, c = p & 7;
      vr[i] = *(const u32x4*)(vT + (size_t)d * S_ + key0 + 8 * c);
    }
    if (BIAS && tid < 64) pr = posb[key0 + tid];
  };
  auto lstore = [&]() {
#pragma unroll
    for (int i = 0; i < NP; ++i) {
      int p = tid + 256 * i, row = p / NPC, c = p % NPC;
      *(u32x4*)(Ks + row * KST + 8 * c) = kr[i];
    }
#pragma unroll
    for (int i = 0; i < 2; ++i) {
      int p = tid + 256 * i, d = p >> 3, c = p & 7;
      u32x2 lo = {vr[i][0], vr[i][1]}, hi = {vr[i][2], vr[i][3]};
      *(u32x2*)(Vs + d * 68 + 8 * c) = lo;
      *(u32x2*)(Vs + d * 68 + 8 * c + 4) = hi;
    }
    if (BIAS && tid < 64) posk[tid] = pr;
  };
  gload(0);
  for (int kt = 0; kt < ntile; ++kt) {
    __syncthreads();
    lstore();
    __syncthreads();
    if (kt + 1 < ntile) gload(kt + 1);
    if (kt <= mylast) {
      f32x16 s0, s1;
#pragma unroll
      for (int i = 0; i < 16; ++i) { s0[i] = 0.f; s1[i] = 0.f; }
#pragma unroll
      for (int s = 0; s < NS; ++s) {
        bf16x8 k0 = *(const bf16x8*)(Ks + l31 * KST + 16 * s + 8 * hh);
        bf16x8 k1 = *(const bf16x8*)(Ks + (32 + l31) * KST + 16 * s + 8 * hh);
        s0 = mfma32(k0, qf[s], s0);
        s1 = mfma32(k1, qf[s], s1);
      }
      bool folded = true;
      float cst = 0.f;
      if (BIAS) {
        const int kmax = pmm[kt * 2 + 1];
        if (qmin - kmax >= 256) {
          cst = lut_s[0];
        } else {
          folded = false;
#pragma unroll
          for (int i = 0; i < 16; ++i) {
            int kk = crow(i, hh);
            int r0 = posk[kk] - posq, r1 = posk[kk + 32] - posq;
            r0 = min(max(r0, -256), 256) + 256;
            r1 = min(max(r1, -256), 256) + 256;
            s0[i] = fmaf(s0[i], scale_l2e, lut_s[r0]);
            s1[i] = fmaf(s1[i], scale_l2e, lut_s[r1]);
          }
        }
      }
      float mx = s0[0];
#pragma unroll
      for (int i = 0; i < 16; ++i) { mx = fmaxf(mx, s0[i]); mx = fmaxf(mx, s1[i]); }
      mx = fmaxf(mx, __shfl_xor(mx, 32));
      if (folded) mx = fmaf(mx, scale_l2e, cst);
      const float mnew = fmaxf(mrun, mx);
      const float alpha = __builtin_amdgcn_exp2f(mrun - mnew);
      mrun = mnew;
      float ps = 0.f;
      const float fsc = folded ? scale_l2e : 1.f;
      const float fof = folded ? cst - mnew : -mnew;
#pragma unroll
      for (int i = 0; i < 16; ++i) {
        s0[i] = __builtin_amdgcn_exp2f(fmaf(s0[i], fsc, fof));
        s1[i] = __builtin_amdgcn_exp2f(fmaf(s1[i], fsc, fof));
        ps += s0[i] + s1[i];
      }
      lrun = lrun * alpha + ps;
#pragma unroll
      for (int i = 0; i < 16; ++i) { oacc[0][i] *= alpha; oacc[1][i] *= alpha; }
#pragma unroll
      for (int st = 0; st < 2; ++st) {
#pragma unroll
        for (int s = 0; s < 2; ++s) {
          u32x4 pp;
          if (st == 0) {
            pp[0] = pack_bf16(s0[8 * s + 0], s0[8 * s + 1]); pp[1] = pack_bf16(s0[8 * s + 2], s0[8 * s + 3]);
            pp[2] = pack_bf16(s0[8 * s + 4], s0[8 * s + 5]); pp[3] = pack_bf16(s0[8 * s + 6], s0[8 * s + 7]);
          } else {
            pp[0] = pack_bf16(s1[8 * s + 0], s1[8 * s + 1]); pp[1] = pack_bf16(s1[8 * s + 2], s1[8 * s + 3]);
            pp[2] = pack_bf16(s1[8 * s + 4], s1[8 * s + 5]); pp[3] = pack_bf16(s1[8 * s + 6], s1[8 * s + 7]);
          }
          bf16x8 pf = __builtin_bit_cast(bf16x8, pp);
#pragma unroll
          for (int mt = 0; mt < 2; ++mt) {
            const bf16_t* vp = Vs + (32 * mt + l31) * 68 + 32 * st + 16 * s + 4 * hh;
            u32x2 a = *(const u32x2*)vp, b = *(const u32x2*)(vp + 8);
            u32x4 vv = {a[0], a[1], b[0], b[1]};
            oacc[mt] = mfma32(__builtin_bit_cast(bf16x8, vv), pf, oacc[mt]);
          }
        }
      }
    }
  }
  const float ltot = lrun + __shfl_xor(lrun, 32);
  const float inv = 1.f / ltot;
  const size_t orow = (size_t)(tok0 + qrow) * ostride;
#pragma unroll
  for (int mt = 0; mt < 2; ++mt)
#pragma unroll
    for (int g = 0; g < 4; ++g) {
      int d = 32 * mt + 8 * g + 4 * hh;
      float v0 = oacc[mt][4 * g] * inv, v1 = oacc[mt][4 * g + 1] * inv, v2 = oacc[mt][4 * g + 2] * inv, v3 = oacc[mt][4 * g + 3] * inv;
      if (ob) {
        u32x2 pk = {pack_bf16(v0, v1), pack_bf16(v2, v3)};
        *(u32x2*)(ob + orow + d) = pk;
      } else {
        f32x4 o = {v0, v1, v2, v3};
        *(f32x4*)(of + orow + d) = o;
      }
    }
}

DI void top16_insert(float (&v)[16], int (&id)[16], float x, int xi) {
  if (x > v[15]) {
#pragma unroll
    for (int p = 0; p < 16; ++p) {
      bool gt = x > v[p];
      float tv = gt ? v[p] : x; int ti = gt ? id[p] : xi;
      v[p] = gt ? x : v[p]; id[p] = gt ? xi : id[p];
      x = tv; xi = ti;
    }
  }
}
DI void top16_merge(float (&v)[16], int (&id)[16]) {
  float nv[16]; int ni[16];
#pragma unroll
  for (int i = 0; i < 16; ++i) {
    float pv = __shfl_xor(v[15 - i], 1); int pi = __shfl_xor(id[15 - i], 1);
    bool take = (pv > v[i]) || (pv == v[i] && pi < id[i]);
    nv[i] = take ? pv : v[i]; ni[i] = take ? pi : id[i];
  }
#pragma unroll
  for (int i = 0; i < 16; ++i) { v[i] = nv[i]; id[i] = ni[i]; }
}

DI unsigned mono_key(float f) { unsigned u = __float_as_uint(f); return (u >> 31) ? ~u : (u | 0x80000000u); }
DI float key_val(unsigned k) { return __uint_as_float((k >> 31) ? (k & 0x7fffffffu) : ~k); }
DI void ce_desc(unsigned& a, unsigned& b) { unsigned hi = a > b ? a : b, lo = a > b ? b : a; a = hi; b = lo; }
DI void sort8_desc(unsigned (&k)[8]) {
  ce_desc(k[0], k[1]); ce_desc(k[2], k[3]); ce_desc(k[4], k[5]); ce_desc(k[6], k[7]);
  ce_desc(k[0], k[2]); ce_desc(k[1], k[3]); ce_desc(k[4], k[6]); ce_desc(k[5], k[7]);
  ce_desc(k[1], k[2]); ce_desc(k[5], k[6]);
  ce_desc(k[0], k[4]); ce_desc(k[1], k[5]); ce_desc(k[2], k[6]); ce_desc(k[3], k[7]);
  ce_desc(k[2], k[4]); ce_desc(k[3], k[5]);
  ce_desc(k[1], k[2]); ce_desc(k[3], k[4]); ce_desc(k[5], k[6]);
}
DI void sort4_desc(unsigned (&k)[4]) {
  ce_desc(k[0], k[1]); ce_desc(k[2], k[3]); ce_desc(k[0], k[2]); ce_desc(k[1], k[3]); ce_desc(k[1], k[2]);
}
DI unsigned umax_dpp(unsigned m, int) { return m; }
template <int N>
DI unsigned dpp_top16(unsigned (&k)[N], int j16) {
  unsigned res = 0;
#pragma unroll
  for (int r = 0; r < 16; ++r) {
    unsigned m = k[0], t;
    t = (unsigned)__builtin_amdgcn_update_dpp(0, (int)m, 0xB1, 0xf, 0xf, true); m = m > t ? m : t;
    t = (unsigned)__builtin_amdgcn_update_dpp(0, (int)m, 0x4E, 0xf, 0xf, true); m = m > t ? m : t;
    t = (unsigned)__builtin_amdgcn_update_dpp(0, (int)m, 0x141, 0xf, 0xf, true); m = m > t ? m : t;
    t = (unsigned)__builtin_amdgcn_update_dpp(0, (int)m, 0x140, 0xf, 0xf, true); m = m > t ? m : t;
    const bool win = k[0] == m;
#pragma unroll
    for (int i = 0; i < N - 1; ++i) k[i] = win ? k[i + 1] : k[i];
    k[N - 1] = win ? 0u : k[N - 1];
    res = (j16 == r) ? m : res;
  }
  return res;
}

enum { PH_PRO = 0, PH_E1, PH_E2, PH_E3, PH_E4, PH_E5, PH_E6, PH_MIXO, PH_LN1, PH_P1, PH_P2, PH_P3, PH_G2, PH_O1, PH_O2, PH_O3, PH_P3B };

struct PhaseDesc { int kind; int layer; };

__device__ __forceinline__ void run_phase(const Params& P, int kind, int L, char* lds, bool dry) {
  int tid_ = threadIdx.x, bid_ = blockIdx.x;
  asm volatile("" : "+v"(tid_));
  asm volatile("" : "+s"(bid_));
  const int tid = tid_, lane = tid & 63, w = tid >> 6;
  const int nb = gridDim.x, bid = bid_;
  const int xcd = bid & 7, li = bid >> 3, nloc = nb >> 3;
  char* ws = P.ws;
  bf16_t* Wb = (bf16_t*)(ws + OFF_W);
  unsigned char* tabU = (unsigned char*)(ws + OFF_TABU);
  unsigned char* tabV = (unsigned char*)(ws + OFF_TABU + 16 * MiB);
  float* sclU = (float*)(ws + OFF_MISC + 6 * MiB);
  float* sclV = sclU + 16384;
  float* Hf = (float*)(ws + OFF_H);
  bf16_t* hbA = (bf16_t*)(ws + OFF_HBA);
  bf16_t* hbB = (bf16_t*)(ws + OFF_HBB);
  bf16_t* RA = (bf16_t*)(ws + OFF_RA);
  char* RB = ws + OFF_RB;
  bf16_t* RO = (bf16_t*)(ws + OFF_RO);
  float* OD = (float*)(ws + OFF_OD);
  int* pe_idx = (int*)(ws + OFF_PK);
  float* pe_g = (float*)(ws + OFF_PK + 16 * MiB);
  char* MS = ws + OFF_MISC;
  float* cstab = (float*)(MS + MS_CS);
  float* lutB = (float*)(MS + MS_LUTB);
  float* lutC = (float*)(MS + MS_LUTC);
  int* pmm = (int*)(MS + MS_PMM);
  float* lamv = (float*)(MS + MS_LAM);
  float* rsq = (float*)(MS + MS_RSQ);
  float* rskv = (float*)(MS + MS_RSKV);
  const int j = L >> 1;
  const bf16_t* We = Wb + (size_t)j * WE_SZ;
  const bf16_t* Wo = Wb + WO_BASE + (size_t)j * WO_SZ;
  const bf16_t* Wl = Wb + WL_BASE + (size_t)L * WL_SZ;

  switch (kind) {
  case PH_PRO: {
    {
      int base = 0;
#pragma unroll 1
      for (int job = 0; job < 24; ++job) {
        const float* src; const float* gsc = nullptr; bf16_t* dst; int K, N, Np;
        if (job < 12) {
          const int jj = job / 6, k = job % 6;
          bf16_t* W = Wb + (size_t)jj * WE_SZ;
          bf16_t* W2 = Wb + WO_BASE + (size_t)jj * WO_SZ;
          if (k == 0) { src = P.ev_w_in + (size_t)jj * 1024 * 2336; K = 1024; N = 2336; Np = NE; dst = W + WE_IN; }
          else if (k == 1) { src = P.ev_w_uq + (size_t)jj * 512 * 768; K = 512; N = 768; Np = 768; dst = W + WE_UQ; gsc = P.ev_q_norm + jj * 512; }
          else if (k == 2) { src = P.ev_w_ukv + (size_t)jj * 256 * 1024; K = 256; N = 1024; Np = 1024; dst = W + WE_UKV; gsc = P.ev_kv_norm + jj * 256; }
          else if (k == 3) { src = P.ev_w_o + (size_t)jj * 1024 * 1024; K = 1024; N = 1024; Np = 1024; dst = W + WE_O; }
          else if (k == 4) { src = P.od_w_in + (size_t)jj * 1024 * 2640; K = 1024; N = 2640; Np = NO; dst = W2 + WO_IN; }
          else { src = P.od_w_o + (size_t)jj * 1024 * 1024; K = 1024; N = 1024; Np = 1024; dst = W2 + WO_O; }
        } else {
          const int l = (job - 12) / 3, k = (job - 12) % 3;
          bf16_t* W = Wb + WL_BASE + (size_t)l * WL_SZ;
          if (k == 0) { src = P.peer_w_q + (size_t)l * 1024 * 2048; K = 1024; N = 2048; Np = 2048; dst = W + WL_Q; }
          else if (k == 1) { src = P.ple_gate_w + (size_t)l * 1024 * 1024; K = 1024; N = 1024; Np = 1024; dst = W + WL_G; }
          else { src = P.ple_w + (size_t)l * 256 * 1024; K = 256; N = 1024; Np = 1024; dst = W + WL_PLE; }
        }
        const int n = (K >> 6) * (Np >> 6);
        for (int it = bid - base; it < n; it += nb) if (it >= 0) tconv_item(src, K, N, Np, dst, gsc, it, lds);
        base = (base + n) % nb;
      }
      for (int it = bid; it < 64; it += nb) {
        const int l = it >> 4, k = (it >> 3) & 1, i8 = it & 7;
        bf16_t* W = Wb + WL_BASE + (size_t)l * WL_SZ;
        conv_item((k ? P.peer_k2 : P.peer_k1) + (size_t)l * 16384, W + (k ? WL_K2 : WL_K1), i8);
      }
    }
    for (int it = bid; it < 16384; it += nb) conv_item(P.x, hbB, it);
    for (int it = bid; it < 2048; it += nb) {
      int idx = it * 256 + tid, t = idx >> 4, f = idx & 15;
      float freq = powf(10000.f, -(float)f / 16.f);
      float ang = (float)P.pos[t] * freq;
      float sn, cs;
      sincosf(ang, &sn, &cs);
      cstab[2 * idx] = cs; cstab[2 * idx + 1] = sn;
    }
    if (bid == 0) {
      for (int i = tid; i < 8 * 513; i += 256) { int hd = i / 513, r = i % 513; lutB[hd * 520 + r] = P.rel_bias[t5_bucket(r - 256) * 24 + hd] * L2E; }
      for (int i = tid; i < 16 * 513; i += 256) { int r = i >> 4, hd = i & 15; lutC[r * 16 + hd] = P.rel_bias[t5_bucket(r - 256) * 24 + 8 + hd] * L2E; }
      for (int i = tid; i < 512; i += 256) {
        int mn = 0x7fffffff, mx = -0x7fffffff;
        for (int k = 0; k < 64; ++k) { int v = P.pos[i * 64 + k]; mn = v < mn ? v : mn; mx = v > mx ? v : mx; }
        pmm[2 * i] = mn; pmm[2 * i + 1] = mx;
      }
      if (tid < 2) {
        float a = 0.f, b = 0.f;
        for (int k = 0; k < 32; ++k) { a += P.lq1[tid * 32 + k] * P.lk1[tid * 32 + k]; b += P.lq2[tid * 32 + k] * P.lk2[tid * 32 + k]; }
        float lam_init = 0.8f - 0.6f * expf(-0.3f * (float)(2 * tid));
        lamv[2 * tid] = expf(a) - expf(b) + lam_init;
        lamv[2 * tid + 1] = lam_init;
      }
    }
  } break;

  case PH_E1: {
    EpiEvenProj epi{RA, (bf16_t*)(RB + RB_VTD)};
    const int ntn = NE / 128;
#ifdef GEMM_EXP
    if (dry) {
      EpiEvenProj epd{(bf16_t*)OD, (bf16_t*)OD + 80 * MiB / 2};
      for (int it = bid; it < 128 * ntn; it += nb) gemm_tile<4, false, GEMM_EXP>(hbB, 1024, We + WE_IN, 1024, (it / ntn) * 256, (it % ntn) * 128, lds, epd);
      break;
    }
#endif
    for (int j = li; j < 16 * ntn; j += nloc) gemm_tile<4>(hbB, 1024, We + WE_IN, 1024, (xcd + 8 * (j / ntn)) * 256, (j % ntn) * 128, lds, epi);
  } break;

  case PH_E2: {
    for (int it = bid; it < T_ / 4; it += nb) {
      int t = it * 4 + w;
      const bf16_t* row = RA + (size_t)t * NE;
      u32x4 a = *(const u32x4*)(row + 8 * lane);
      float ss = 0.f;
#pragma unroll
      for (int e = 0; e < 4; ++e) { float lo = bf_lo(a[e]), hi = bf_hi(a[e]); ss += lo * lo + hi * hi; }
      ss = wave_sum(ss);
      u32x2 c = *(const u32x2*)(row + 512 + 4 * lane);
      float s2 = 0.f;
#pragma unroll
      for (int e = 0; e < 2; ++e) { float lo = bf_lo(c[e]), hi = bf_hi(c[e]); s2 += lo * lo + hi * hi; }
      s2 = wave_sum(s2);
      if (lane == 0) { rsq[t] = rsqrtf(ss / 512.f + 1e-6f); rskv[t] = rsqrtf(s2 / 256.f + 1e-6f); }
      if (lane < 16) {
        bf16_t* kr = RA + (size_t)t * NE + 768;
        float x1 = bf2f(kr[lane]), x2 = bf2f(kr[16 + lane]);
        float cs = cstab[(t * 16 + lane) * 2], sn = cstab[(t * 16 + lane) * 2 + 1];
        kr[lane] = f2bf(x1 * cs - x2 * sn);
        kr[16 + lane] = f2bf(x2 * cs + x1 * sn);
      }
    }
  } break;

  case PH_E3: {
    EpiRowScaleBf16 e1{(bf16_t*)(RB + RB_QA), 768, rsq};
    EpiKV e2{(bf16_t*)(RB + RB_KN), (bf16_t*)(RB + RB_VTA), rskv};
    const int n1 = 128 * 6, n2 = 128 * 8;
    int j = li;
    for (; j < 96; j += nloc) gemm_tile<4>(RA, NE, We + WE_UQ, 512, (xcd + 8 * (j / 6)) * 256, (j % 6) * 128, lds, e1);
    for (; j < 96 + 128; j += nloc) { int j2 = j - 96; gemm_tile<4>(RA + 512, NE, We + WE_UKV, 256, (xcd + 8 * (j2 >> 3)) * 256, (j2 & 7) * 128, lds, e2); }
  } break;

  case PH_E4: {
    bf16_t* qa = (bf16_t*)(RB + RB_QA);
    for (int it = bid; it < 16384; it += nb) {
      int idx = it * 256 + tid, t = idx >> 7, hd = (idx >> 4) & 7, f = idx & 15;
      bf16_t* q = qa + (size_t)t * 768 + hd * 96 + 64;
      float x1 = bf2f(q[f]), x2 = bf2f(q[16 + f]);
      float cs = cstab[(t * 16 + f) * 2], sn = cstab[(t * 16 + f) * 2 + 1];
      q[f] = f2bf(x1 * cs - x2 * sn);
      q[16 + f] = f2bf(x2 * cs + x1 * sn);
    }
  } break;

  case PH_E5: {
    const bf16_t* qa = (const bf16_t*)(RB + RB_QA);
    const bf16_t* kn = (const bf16_t*)(RB + RB_KN);
    const bf16_t* vTa = (const bf16_t*)(RB + RB_VTA);
    const bf16_t* vTd = (const bf16_t*)(RB + RB_VTD);
    for (int rr = li >> 5; rr < 24; rr += ((nloc >> 5) > 0 ? (nloc >> 5) : 1)) {
      const int combo = xcd + 8 * rr;
      const int qt = ((rr >> 1) & 1) ? (li & 31) : 31 - (li & 31);
      const int b = combo / 24, u = combo % 24;
      int tok0 = b * S_;
      if (u < 8) {
        attn_item<96, false>(qa + u * 96, 768, kn + u * 64, 512, RA + 768, NE, vTa + (size_t)((b * 8 + u) * 64) * S_,
                             P.pos + tok0, nullptr, pmm + b * 128, tok0, qt, 0.10206207261596577f * L2E, lds,
                             RO + u * 64, nullptr, 1024);
      } else {
        int hd = (u - 8) >> 1, m = (u - 8) & 1;
        attn_item<32, true>(RA + 800 + hd * 64 + m * 32, NE, RA + 1312 + hd * 64 + m * 32, NE, nullptr, 0,
                            vTd + (size_t)((b * 8 + hd) * 64) * S_, P.pos + tok0, lutB + hd * 520, pmm + b * 128, tok0, qt,
                            0.17677669529663687f * L2E, lds, nullptr, OD + (size_t)m * T_ * 512 + hd * 64, 512);
      }
    }
  } break;

  case PH_E6: {
    const float lam = lamv[2 * j], lam_init = lamv[2 * j + 1];
    for (int it = bid; it < 16384; it += nb) {
      int pair = it * 16 + (tid >> 4), t = pair >> 3, hd = pair & 7, d = (tid & 15) * 4;
      f32x4 o1 = *(const f32x4*)(OD + (size_t)t * 512 + hd * 64 + d);
      f32x4 o2 = *(const f32x4*)(OD + (size_t)T_ * 512 + (size_t)t * 512 + hd * 64 + d);
      f32x4 v = o1 - lam * o2;
      float ss = v[0] * v[0] + v[1] * v[1] + v[2] * v[2] + v[3] * v[3];
      ss = row16_sum(ss);
      float r = rsqrtf(ss / 64.f + 1e-6f) * (1.f - lam_init);
      const float* g = P.ev_subln + j * 64 + d;
      u32x2 pk = {pack_bf16(v[0] * r * g[0], v[1] * r * g[1]), pack_bf16(v[2] * r * g[2], v[3] * r * g[3])};
      *(u32x2*)(RO + (size_t)t * 1024 + 512 + hd * 64 + d) = pk;
    }
  } break;

  case PH_MIXO: {
    EpiResid epi{(bf16_t*)RB, L == 0 ? P.x : nullptr, hbB};
    const bf16_t* Wt = (L & 1) ? (Wo + WO_O) : (We + WE_O);
    const int n1 = 128 * 8;
    for (int j = li; j < 128; j += nloc) gemm_tile<4>(RO, 1024, Wt, 1024, (xcd + 8 * (j >> 3)) * 256, (j & 7) * 128, lds, epi);
    for (int it = bid; it < 4096; it += nb) conv_item(P.p + (size_t)L * T_ * 256, (bf16_t*)OD, it);
  } break;

  case PH_LN1: {
    const bf16_t* y = (const bf16_t*)RB;
    const float* g = P.ln1_g + L * 1024; const float* bb = P.ln1_b + L * 1024;
    for (int it = bid; it < T_ / 4; it += nb) {
      int t = it * 4 + w;
      f32x4 v[4]; float s = 0.f;
#pragma unroll
      for (int k = 0; k < 4; ++k) {
        const u32x2 yy = *(const u32x2*)(y + (size_t)t * 1024 + 256 * k + 4 * lane);
        v[k] = f32x4{bf_lo(yy[0]), bf_hi(yy[0]), bf_lo(yy[1]), bf_hi(yy[1])};
        s += v[k][0] + v[k][1] + v[k][2] + v[k][3];
      }
      float mu = wave_sum(s) * (1.f / 1024.f);
      float q = 0.f;
#pragma unroll
      for (int k = 0; k < 4; ++k) { v[k] -= mu; q += v[k][0] * v[k][0] + v[k][1] * v[k][1] + v[k][2] * v[k][2] + v[k][3] * v[k][3]; }
      float rstd = rsqrtf(wave_sum(q) * (1.f / 1024.f) + 1e-5f);
      if (lane == 0) { f32x2 st = {mu, rstd}; *(f32x2*)(MS + 8 * MiB + (size_t)t * 8) = st; }
#pragma unroll
      for (int k = 0; k < 4; ++k) {
        int c = 256 * k + 4 * lane;
        f32x4 gg = *(const f32x4*)(g + c), b4 = *(const f32x4*)(bb + c);
        f32x4 o = v[k] * rstd * gg + b4;
        u32x2 pk = {pack_bf16(o[0], o[1]), pack_bf16(o[2], o[3])};
        *(u32x2*)(hbA + (size_t)t * 1024 + c) = pk;
      }
    }
  } break;

  case PH_P1: {
    EpiBf16 e1{RA, 2048, 2048};
    EpiBf16 e2{RO, 1024, 1024};
    const int n1 = 128 * 16, n2 = 128 * 8, n3 = 4096;
    int j = li;
    for (; j < 256; j += nloc) gemm_tile<4>(hbA, 1024, Wl + WL_Q, 1024, (xcd + 8 * (j >> 4)) * 256, (j & 15) * 128, lds, e1);
    for (; j < 256 + 128; j += nloc) { int j2 = j - 256; gemm_tile<4>((const bf16_t*)OD, 256, Wl + WL_PLE, 256, (xcd + 8 * (j2 >> 3)) * 256, (j2 & 7) * 128, lds, e2); }
    for (int it = bid; it < n3; it += nb) convfp8_item(P.peer_u + (size_t)L * 16384 * 1024, tabU, sclU, it);
    for (int it = bid; it < n3; it += nb) convfp8_item(P.peer_v + (size_t)L * 16384 * 1024, tabV, sclV, it);
  } break;

  case PH_P2: {
    float* st = (float*)lds;
    EpiLds epi{st};
    const int j16 = lane & 15, rr = lane >> 4;
    int ccode[4];
#pragma unroll
    for (int m = 0; m < 4; ++m) {
      int n = j16 + 16 * m, code = 255;
      if (n < 50) {
        int a = 0;
        for (; a < 16; ++a) { int cnt = 16 / (a + 1); if (n < cnt) break; n -= cnt; }
        code = a * 16 + n;
      }
      ccode[m] = code;
    }
    unsigned* T1 = (unsigned*)pe_idx;
    unsigned* T2 = (unsigned*)pe_g;
    for (int it = bid; it < 2048; it += nb) {
      const int mt = it >> 3, hd = it & 7;
#pragma unroll 1
      for (int half = 0; half < 2; ++half) {
        gemm_tile<2, true>(RA + hd * 256 + half * 128, 2048, Wl + (half ? WL_K2 : WL_K1), 128, mt * 128, 0, lds, epi);
        __syncthreads();
        unsigned* Th = half ? T2 : T1;
#pragma unroll 1
        for (int tk = 0; tk < 8; ++tk) {
          const int row = (w * 8 + tk) * 4 + rr;
          unsigned k[8];
#pragma unroll
          for (int m = 0; m < 8; ++m) {
            const int c = j16 + 16 * m;
            k[m] = (mono_key(st[row * 128 + ((c + row) & 127)]) & ~127u) | (unsigned)(127 - c);
          }
          sort8_desc(k);
          Th[(size_t)(mt * 128 + row) * 128 + hd * 16 + j16] = dpp_top16<8>(k, j16);
        }
        __syncthreads();
      }
#pragma unroll 1
      for (int tk = 0; tk < 8; ++tk) {
        const int row = (w * 8 + tk) * 4 + rr;
        const size_t obase = (size_t)(mt * 128 + row) * 128 + hd * 16;
        unsigned k[4];
#pragma unroll
        for (int m = 0; m < 4; ++m) {
          const int code = ccode[m];
          const float va = key_val(T1[obase + ((code >> 4) & 15)] & ~127u);
          const float vb = key_val(T2[obase + (code & 15)] & ~127u);
          k[m] = code < 255 ? ((mono_key(va + vb) & ~255u) | (unsigned)(255 - code)) : 0u;
        }
        sort4_desc(k);
        const unsigned kk = dpp_top16<4>(k, j16);
        const int code = 255 - (int)(kk & 255u);
        const float v = key_val(kk & ~255u);
        float mx = v;
        mx = fmaxf(mx, __builtin_bit_cast(float, __builtin_amdgcn_update_dpp(0, __builtin_bit_cast(int, mx), 0xB1, 0xf, 0xf, true)));
        mx = fmaxf(mx, __builtin_bit_cast(float, __builtin_amdgcn_update_dpp(0, __builtin_bit_cast(int, mx), 0x4E, 0xf, 0xf, true)));
        mx = fmaxf(mx, __builtin_bit_cast(float, __builtin_amdgcn_update_dpp(0, __builtin_bit_cast(int, mx), 0x141, 0xf, 0xf, true)));
        mx = fmaxf(mx, __builtin_bit_cast(float, __builtin_amdgcn_update_dpp(0, __builtin_bit_cast(int, mx), 0x140, 0xf, 0xf, true)));
        const float e = __expf(v - mx);
        const float sum = row16_sum(e);
        const int i1 = 127 - (int)(T1[obase + (code >> 4)] & 127u);
        const int i2 = 127 - (int)(T2[obase + (code & 15)] & 127u);
        pe_idx[obase + j16] = i1 * 128 + i2;
        pe_g[obase + j16] = e / sum;
      }
    }
  } break;

  case PH_P3:
  case PH_P3B: {
    const bool st1 = kind == PH_P3;
    float* cbuf = OD + 4 * 1024 * 1024;
    int* idx_s = (int*)lds + w * 640;
    float* g_s = (float*)(idx_s + 128);
    float* c_s = (float*)(idx_s + 256);
    float* su_s = (float*)(idx_s + 384);
    float* sv_s = (float*)(idx_s + 512);
    const float* g2 = P.ln2_g + L * 1024; const float* b2 = P.ln2_b + L * 1024;
    const int jl = lane & 15, grp = lane >> 4;
    for (int it = bid; it < T_ / 4; it += nb) {
      const int t = it * 4 + w;
      idx_s[lane] = pe_idx[(size_t)t * 128 + lane]; idx_s[64 + lane] = pe_idx[(size_t)t * 128 + 64 + lane];
      if (!st1) {
        c_s[lane] = cbuf[(size_t)t * 128 + lane]; c_s[64 + lane] = cbuf[(size_t)t * 128 + 64 + lane];
      }
      if (st1) {
      g_s[lane] = pe_g[(size_t)t * 128 + lane]; g_s[64 + lane] = pe_g[(size_t)t * 128 + 64 + lane];
      u32x4 xq[4][2];
#pragma unroll
      for (int i = 0; i < 4; ++i) {
        xq[i][0] = *(const u32x4*)(hbA + (size_t)t * 1024 + 256 * i + 16 * jl);
        xq[i][1] = *(const u32x4*)(hbA + (size_t)t * 1024 + 256 * i + 16 * jl + 8);
      }
      su_s[lane] = sclU[idx_s[lane]]; su_s[64 + lane] = sclU[idx_s[64 + lane]];
      sv_s[lane] = sclV[idx_s[lane]]; sv_s[64 + lane] = sclV[idx_s[64 + lane]];
      auto ld1 = [&](u32x4 (&u)[4], int k4) {
        const unsigned char* ur = tabU + (size_t)idx_s[4 * k4 + grp] * 1024 + 16 * jl;
#pragma unroll
        for (int i = 0; i < 4; ++i) u[i] = *(const u32x4*)(ur + 256 * i);
      };
      auto cp1 = [&](const u32x4 (&u)[4], int k4) {
        float acc = 0.f;
#pragma unroll
        for (int i = 0; i < 4; ++i) {
#pragma unroll
          for (int k = 0; k < 4; ++k) {
            bf16x2v lo = __builtin_amdgcn_cvt_scalef32_pk_bf16_fp8((int)u[i][k], 1.0f, false);
            bf16x2v hi = __builtin_amdgcn_cvt_scalef32_pk_bf16_fp8((int)u[i][k], 1.0f, true);
            unsigned x0 = xq[i][k >> 1][(2 * k) & 3], x1 = xq[i][k >> 1][(2 * k + 1) & 3];
            acc = __builtin_amdgcn_fdot2_f32_bf16(lo, __builtin_bit_cast(bf16x2v, x0), acc, false);
            acc = __builtin_amdgcn_fdot2_f32_bf16(hi, __builtin_bit_cast(bf16x2v, x1), acc, false);
          }
        }
        acc = row16_sum(acc) * su_s[4 * k4 + grp];
        float x3 = acc * acc * acc;
        float z = 0.7978845608028654f * (acc + 0.044715f * x3);
        float ez = __expf(2.f * z);
        float th = 1.f - 2.f / (ez + 1.f);
        float ge = 0.5f * acc * (1.f + th);
        if (jl == 0) c_s[4 * k4 + grp] = g_s[4 * k4 + grp] * ge * sv_s[4 * k4 + grp];
      };
      {
        u32x4 u0[4], u1[4], u2[4];
        ld1(u0, 0); ld1(u1, 1);
#pragma unroll 1
        for (int k4 = 0; k4 < 30; k4 += 3) {
          ld1(u2, k4 + 2); cp1(u0, k4);
          ld1(u0, k4 + 3); cp1(u1, k4 + 1);
          ld1(u1, k4 + 4); cp1(u2, k4 + 2);
        }
        cp1(u0, 30); cp1(u1, 31);
      }
      cbuf[(size_t)t * 128 + lane] = c_s[lane]; cbuf[(size_t)t * 128 + 64 + lane] = c_s[64 + lane];
      continue;
      }
      float out[16];
#pragma unroll
      for (int i = 0; i < 16; ++i) out[i] = 0.f;
      auto ld2 = [&](u32x4 (&v)[8], int kb) {
#pragma unroll
        for (int k = 0; k < 8; ++k) v[k] = *(const u32x4*)(tabV + (size_t)idx_s[8 * kb + k] * 1024 + 16 * lane);
      };
      auto cp2 = [&](const u32x4 (&v)[8], int kb) {
#pragma unroll
        for (int k = 0; k < 8; ++k) {
          const float c = c_s[8 * kb + k];
#pragma unroll
          for (int e = 0; e < 4; ++e) {
            f32x2 lo = __builtin_amdgcn_cvt_pk_f32_fp8((int)v[k][e], false);
            f32x2 hi = __builtin_amdgcn_cvt_pk_f32_fp8((int)v[k][e], true);
            out[4 * e] = fmaf(c, lo[0], out[4 * e]); out[4 * e + 1] = fmaf(c, lo[1], out[4 * e + 1]);
            out[4 * e + 2] = fmaf(c, hi[0], out[4 * e + 2]); out[4 * e + 3] = fmaf(c, hi[1], out[4 * e + 3]);
          }
        }
      };
      {
        u32x4 v0[8], v1[8];
        ld2(v0, 0);
#pragma unroll 1
        for (int kb = 0; kb < 16; kb += 2) {
          ld2(v1, kb + 1); cp2(v0, kb);
          if (kb + 2 < 16) ld2(v0, kb + 2);
          cp2(v1, kb + 1);
        }
      }
      float* hr = Hf + (size_t)t * 1024 + 16 * lane;
      float* hw = hr;
      const f32x2 st1v = *(const f32x2*)(MS + 8 * MiB + (size_t)t * 8);
      bf16_t* hbw = (dry ? RA : hbA) + (size_t)t * 1024 + 16 * lane;
      float s = 0.f;
#pragma unroll
      for (int k = 0; k < 4; ++k) {
        const u32x2 yy = *(const u32x2*)((const bf16_t*)RB + (size_t)t * 1024 + 16 * lane + 4 * k);
        const f32x4 yv = {bf_lo(yy[0]), bf_hi(yy[0]), bf_lo(yy[1]), bf_hi(yy[1])};
        const f32x4 g1 = *(const f32x4*)(P.ln1_g + L * 1024 + 16 * lane + 4 * k);
        const f32x4 b1 = *(const f32x4*)(P.ln1_b + L * 1024 + 16 * lane + 4 * k);
        const f32x4 a = (yv - st1v[0]) * st1v[1] * g1 + b1;
#pragma unroll
        for (int e = 0; e < 4; ++e) { out[4 * k + e] += DN_ALPHA * a[e]; s += out[4 * k + e]; }
      }
      float mu = wave_sum(s) * (1.f / 1024.f);
      float q = 0.f;
#pragma unroll
      for (int i = 0; i < 16; ++i) { out[i] -= mu; q += out[i] * out[i]; }
      float rstd = rsqrtf(wave_sum(q) * (1.f / 1024.f) + 1e-5f);
      unsigned pk[8];
#pragma unroll
      for (int k = 0; k < 4; ++k) {
        f32x4 ga = *(const f32x4*)(g2 + 16 * lane + 4 * k), ba = *(const f32x4*)(b2 + 16 * lane + 4 * k);
        f32x4 oa;
#pragma unroll
        for (int e = 0; e < 4; ++e) oa[e] = out[4 * k + e] * rstd * ga[e] + ba[e];
        pk[2 * k] = pack_bf16(oa[0], oa[1]); pk[2 * k + 1] = pack_bf16(oa[2], oa[3]);
      }
      u32x4 p0 = {pk[0], pk[1], pk[2], pk[3]}, p1 = {pk[4], pk[5], pk[6], pk[7]};
      *(u32x4*)hbw = p0; *(u32x4*)(hbw + 8) = p1;
    }
  } break;

  case PH_G2: {
    EpiGate epi{hbA, dry ? (float*)RB : (L == 3 ? P.out : nullptr), dry ? RA : hbB, RO, P.ple_gate_b + L * 1024};
    for (int j = li; j < 128; j += nloc) gemm_tile<4>(hbA, 1024, Wl + WL_G, 1024, (xcd + 8 * (j >> 3)) * 256, (j & 7) * 128, lds, epi);
  } break;

  case PH_O1: {
    EpiBf16 epi{RA, NO, 2640};
    const int ntn = NO / 128;
    for (int j = li; j < 16 * ntn; j += nloc) gemm_tile<4>(hbB, 1024, Wo + WO_IN, 1024, (xcd + 8 * (j / ntn)) * 256, (j % ntn) * 128, lds, epi);
  } break;

  case PH_O2: {
    {
      unsigned char* kv8 = (unsigned char*)(RB + 128 * MiB);
      for (int it = bid; it < 8192; it += nb) {
        const int idx = it * 256 + tid, t = idx >> 6, e8 = idx & 63;
        const u32x4 v = *(const u32x4*)(RA + (size_t)t * NO + 1024 + 8 * e8);
        int p0 = 0, p1 = 0;
        p0 = __builtin_amdgcn_cvt_pk_fp8_f32(bf_lo(v[0]), bf_hi(v[0]), p0, false);
        p0 = __builtin_amdgcn_cvt_pk_fp8_f32(bf_lo(v[1]), bf_hi(v[1]), p0, true);
        p1 = __builtin_amdgcn_cvt_pk_fp8_f32(bf_lo(v[2]), bf_hi(v[2]), p1, false);
        p1 = __builtin_amdgcn_cvt_pk_fp8_f32(bf_lo(v[3]), bf_hi(v[3]), p1, true);
        u32x2 o = {(unsigned)p0, (unsigned)p1};
        *(u32x2*)(kv8 + (size_t)t * 512 + 8 * e8) = o;
      }
    }
    for (int it = bid; it < 34816; it += nb) {
      int idx = it * 256 + tid, t = idx / 272, r = idx % 272, hd = r >> 4, f = r & 15;
      bf16_t* q = RA + (size_t)t * NO + (hd < 16 ? 1536 + hd * 64 : 2560);
      float x1 = bf2f(q[f]), x2 = bf2f(q[16 + f]);
      float cs = cstab[(t * 16 + f) * 2], sn = cstab[(t * 16 + f) * 2 + 1];
      q[f] = f2bf(x1 * cs - x2 * sn);
      q[16 + f] = f2bf(x2 * cs + x1 * sn);
    }
  } break;

  case PH_O3: {
    float* scr = (float*)RB + (size_t)bid * 16 * 4096;
    char* qi_s = lds;
    float* w_s = (float*)(lds + 33024);
    int* sel = (int*)lds + w * 256;
    bf16_t* q_s = (bf16_t*)(lds + 4096) + w * 1024;
    float* p_s = (float*)(lds + 12288) + w * 1024;
    int* rel_s = (int*)(lds + 28672) + w * 256;
    const unsigned char* kv8 = (const unsigned char*)(RB + 128 * MiB);
    for (int it = bid; it < 2048; it += nb) {
      const int qtile = 255 - (it >> 3), b = it & 7;
      const int q0 = qtile * 16, tok0 = b * S_;
      const int nk = 64 * ((q0 >> 6) + 1);
      __syncthreads();
#pragma unroll
      for (int i = 0; i < 8; ++i) {
        int p = tid + 256 * i, q = p >> 7, c = p & 127;
        *(u32x4*)(qi_s + q * 2064 + c * 16) = *(const u32x4*)(RA + (size_t)(tok0 + q0 + q) * NO + 1536 + 8 * c);
      }
      { int q = tid >> 4, hd = tid & 15; w_s[hd * 16 + q] = bf2f(RA[(size_t)(tok0 + q0 + q) * NO + 2624 + hd]) * (0.25f * 0.125f); }
      __syncthreads();
      const int l15 = lane & 15, kq = lane >> 4;
      if (nk > 256)
      for (int kc = w; kc < (nk >> 6); kc += 4) {
        const int k0 = kc * 64;
        bf16x8 kf[4][2];
#pragma unroll
        for (int tl = 0; tl < 4; ++tl)
#pragma unroll
          for (int s = 0; s < 2; ++s)
            kf[tl][s] = *(const bf16x8*)(RA + (size_t)(tok0 + k0 + 16 * tl + l15) * NO + 2560 + 32 * s + 8 * kq);
        f32x4 sc[4];
#pragma unroll
        for (int tl = 0; tl < 4; ++tl) sc[tl] = f32x4{0.f, 0.f, 0.f, 0.f};
#pragma unroll 1
        for (int hd = 0; hd < 16; ++hd) {
          bf16x8 a0 = *(const bf16x8*)(qi_s + l15 * 2064 + hd * 128 + kq * 16);
          bf16x8 a1 = *(const bf16x8*)(qi_s + l15 * 2064 + hd * 128 + 64 + kq * 16);
          f32x4 wv = *(const f32x4*)(w_s + hd * 16 + 4 * kq);
#pragma unroll
          for (int tl = 0; tl < 4; ++tl) {
            f32x4 d = f32x4{0.f, 0.f, 0.f, 0.f};
            d = mfma16(a0, kf[tl][0], d);
            d = mfma16(a1, kf[tl][1], d);
#pragma unroll
            for (int jj = 0; jj < 4; ++jj) sc[tl][jj] = fmaf(wv[jj], fmaxf(d[jj], 0.f), sc[tl][jj]);
          }
        }
#pragma unroll
        for (int tl = 0; tl < 4; ++tl)
#pragma unroll
          for (int jj = 0; jj < 4; ++jj) __builtin_nontemporal_store(sc[tl][jj], scr + (4 * kq + jj) * 4096 + k0 + 16 * tl + l15);
      }
      __syncthreads();
      for (int qq = 0; qq < 4; ++qq) {
        const int q = 4 * w + qq, tok = tok0 + q0 + q;
        int nvalid;
        if (nk <= 256) {
#pragma unroll
          for (int r = 0; r < 4; ++r) { int slot = lane + 64 * r; if (slot < nk) sel[slot] = slot; }
          nvalid = nk;
        } else {
          const int nreg = nk >> 6;
          unsigned key[64];
#pragma unroll
          for (int r4 = 0; r4 < 16; ++r4) {
            const u32x4 v = __builtin_nontemporal_load((const u32x4*)(scr + q * 4096 + 256 * r4 + 4 * lane));
            key[4 * r4] = v[0]; key[4 * r4 + 1] = v[1]; key[4 * r4 + 2] = v[2]; key[4 * r4 + 3] = v[3];
          }
#pragma unroll
          for (int r = 0; r < 64; ++r) {
            const unsigned u = key[r];
            const unsigned kk = (u & 0x80000000u) ? ~u : (u | 0x80000000u);
            key[r] = (256 * (r >> 2) + 4 * lane < nk) ? kk : 0u;
          }
          unsigned prefix = 0;
          for (int bit = 31; bit >= 0; --bit) {
            const unsigned cand = prefix | (1u << bit);
            int cl = 0;
#pragma unroll
            for (int g8 = 0; g8 < 8; ++g8) {
              if (8 * g8 < nreg) {
#pragma unroll
                for (int r = 8 * g8; r < 8 * g8 + 8; ++r) cl += (key[r] >= cand) ? 1 : 0;
              }
            }
            cl += __builtin_amdgcn_update_dpp(0, cl, 0xB1, 0xf, 0xf, true);
            cl += __builtin_amdgcn_update_dpp(0, cl, 0x4E, 0xf, 0xf, true);
            cl += __builtin_amdgcn_update_dpp(0, cl, 0x141, 0xf, 0xf, true);
            cl += __builtin_amdgcn_update_dpp(0, cl, 0x140, 0xf, 0xf, true);
            const int cnt = __builtin_amdgcn_readlane(cl, 0) + __builtin_amdgcn_readlane(cl, 16) +
                            __builtin_amdgcn_readlane(cl, 32) + __builtin_amdgcn_readlane(cl, 48);
            if (cnt == 256) { prefix = cand - 1u; break; }
            if (cnt > 256) prefix = cand;
          }
          int cgt = 0;
#pragma unroll
          for (int g8 = 0; g8 < 8; ++g8) {
            if (8 * g8 < nreg) {
#pragma unroll
              for (int r = 8 * g8; r < 8 * g8 + 8; ++r) cgt += __popcll(__ballot(key[r] > prefix));
            }
          }
          const int need = 256 - cgt;
          int base = 0, eqc = 0;
          const unsigned long long ltmask = (1ull << lane) - 1ull;
#pragma unroll
          for (int g8 = 0; g8 < 8; ++g8) {
            if (8 * g8 < nreg) {
#pragma unroll
              for (int r = 8 * g8; r < 8 * g8 + 8; ++r) {
                bool gt = key[r] > prefix, eq = key[r] == prefix;
                unsigned long long meq = __ballot(eq);
                int eqb = eqc + __popcll(meq & ltmask);
                bool take = gt || (eq && eqb < need);
                unsigned long long mt = __ballot(take);
                if (take) sel[base + __popcll(mt & ltmask)] = 256 * (r >> 2) + 4 * lane + (r & 3);
                base += __popcll(mt);
                eqc += __popcll(meq);
              }
            }
          }
          nvalid = 256;
        }
        const int posq = P.pos[tok];
        {
          const bf16_t* qg = RA + (size_t)tok * NO + 16 * lane;
          *(u32x4*)(q_s + 16 * lane) = *(const u32x4*)qg;
          *(u32x4*)(q_s + 16 * lane + 8) = *(const u32x4*)(qg + 8);
        }
        auto ldk = [&](u32x4 (&kr)[4], int g, int jj) {
          const int slot = lane + 64 * jj;
          const int key = slot < nvalid ? sel[slot] : 0;
          const unsigned char* krow = kv8 + (size_t)(tok0 + key) * 512 + g * 64;
#pragma unroll
          for (int c = 0; c < 4; ++c) kr[c] = *(const u32x4*)(krow + 16 * c);
        };
#pragma unroll
        for (int jj = 0; jj < 4; ++jj) {
          const int slot = lane + 64 * jj;
          const int key = slot < nvalid ? sel[slot] : 0;
          int rel = P.pos[tok0 + key] - posq;
          rel_s[slot] = (min(max(rel, -256), 256) + 256) * 16;
        }
        u32x4 kcur[4];
        ldk(kcur, 0, 0);
#pragma unroll 1
        for (int g = 0; g < 4; ++g) {
#pragma unroll 1
          for (int jj = 0; jj < 4; ++jj) {
            const int slot = lane + 64 * jj;
            const bool valid = slot < nvalid;
            const f32x4 bias = *(const f32x4*)(lutC + rel_s[slot] + g * 4);
            u32x4 knxt[4];
            {
              int gn = g, jn = jj + 1;
              if (jn == 4) { jn = 0; gn = g + 1; }
              if (gn < 4) ldk(knxt, gn, jn);
            }
            unsigned kb[32];
#pragma unroll
            for (int d = 0; d < 16; ++d) {
              kb[2 * d] = __builtin_bit_cast(unsigned, __builtin_amdgcn_cvt_scalef32_pk_bf16_fp8((int)kcur[d >> 2][d & 3], 1.0f, false));
              kb[2 * d + 1] = __builtin_bit_cast(unsigned, __builtin_amdgcn_cvt_scalef32_pk_bf16_fp8((int)kcur[d >> 2][d & 3], 1.0f, true));
            }
            f32x4 tv;
#pragma unroll
            for (int hh = 0; hh < 4; ++hh) {
              float a0 = 0.f, a1 = 0.f;
#pragma unroll
              for (int c4 = 0; c4 < 8; c4 += 4) {
                u32x4 qv[4];
#pragma unroll
                for (int c = 0; c < 4; ++c) qv[c] = *(const u32x4*)(q_s + (g * 4 + hh) * 64 + 8 * (c4 + c));
#pragma unroll
                for (int c = 0; c < 4; c += 2) {
                  a0 = dot2(kb[4 * (c4 + c) + 0], qv[c][0], a0); a1 = dot2(kb[4 * (c4 + c + 1) + 0], qv[c + 1][0], a1);
                  a0 = dot2(kb[4 * (c4 + c) + 1], qv[c][1], a0); a1 = dot2(kb[4 * (c4 + c + 1) + 1], qv[c + 1][1], a1);
                  a0 = dot2(kb[4 * (c4 + c) + 2], qv[c][2], a0); a1 = dot2(kb[4 * (c4 + c + 1) + 2], qv[c + 1][2], a1);
                  a0 = dot2(kb[4 * (c4 + c) + 3], qv[c][3], a0); a1 = dot2(kb[4 * (c4 + c + 1) + 3], qv[c + 1][3], a1);
                }
              }
              tv[hh] = valid ? fmaf(a0 + a1, 0.125f * L2E, bias[hh]) : -INFINITY;
            }
            *(f32x4*)(p_s + slot * 4) = tv;
#pragma unroll
            for (int c = 0; c < 4; ++c) kcur[c] = knxt[c];
          }
          f32x4 sc4[4];
#pragma unroll
          for (int jj = 0; jj < 4; ++jj) sc4[jj] = *(const f32x4*)(p_s + (lane + 64 * jj) * 4);
          float inv[4];
#pragma unroll
          for (int hh = 0; hh < 4; ++hh) {
            float mx = fmaxf(fmaxf(sc4[0][hh], sc4[1][hh]), fmaxf(sc4[2][hh], sc4[3][hh]));
            mx = wave_max(mx);
            float sm = 0.f;
#pragma unroll
            for (int jj = 0; jj < 4; ++jj) { sc4[jj][hh] = __builtin_amdgcn_exp2f(sc4[jj][hh] - mx); sm += sc4[jj][hh]; }
            sm = wave_sum(sm);
            inv[hh] = 1.f / sm;
          }
#pragma unroll
          for (int jj = 0; jj < 4; ++jj) {
            f32x4 pv = {sc4[jj][0] * inv[0], sc4[jj][1] * inv[1], sc4[jj][2] * inv[2], sc4[jj][3] * inv[3]};
            *(f32x4*)(p_s + (lane + 64 * jj) * 4) = pv;
          }
          const int ks = lane >> 3, dc = lane & 7;
          f32x2 oa[4][4];
#pragma unroll
          for (int hh = 0; hh < 4; ++hh)
#pragma unroll
            for (int d = 0; d < 4; ++d) oa[hh][d] = f32x2{0.f, 0.f};
          const unsigned char* vbase = kv8 + (size_t)tok0 * 512 + 256 + g * 64 + 8 * dc;
          auto ldv = [&](u32x2& v, int i) {
            const int slot = 8 * i + ks;
            v = *(const u32x2*)(vbase + (size_t)sel[slot < nvalid ? slot : 0] * 512);
          };
          auto cpv = [&](const u32x2& v, int i) {
            const f32x4 pv = *(const f32x4*)(p_s + (8 * i + ks) * 4);
            f32x2 vv[4];
            vv[0] = __builtin_amdgcn_cvt_pk_f32_fp8((int)v[0], false); vv[1] = __builtin_amdgcn_cvt_pk_f32_fp8((int)v[0], true);
            vv[2] = __builtin_amdgcn_cvt_pk_f32_fp8((int)v[1], false); vv[3] = __builtin_amdgcn_cvt_pk_f32_fp8((int)v[1], true);
#pragma unroll
            for (int e = 0; e < 4; ++e) {
#pragma unroll
              for (int hh = 0; hh < 4; ++hh) oa[hh][e] = __builtin_elementwise_fma(f32x2{pv[hh], pv[hh]}, vv[e], oa[hh][e]);
            }
          };
          const int nit = nvalid >> 3;
          u32x2 vr[8];
#pragma unroll
          for (int k = 0; k < 7; ++k) ldv(vr[k], k);
#pragma unroll 1
          for (int i = 0; i < nit; i += 8) {
#pragma unroll
            for (int k = 0; k < 8; ++k) {
              if (i + k + 7 < nit) ldv(vr[(k + 7) & 7], i + k + 7);
              cpv(vr[k], i + k);
            }
          }
#pragma unroll
          for (int hh = 0; hh < 4; ++hh)
#pragma unroll
            for (int d = 0; d < 4; ++d)
#pragma unroll
              for (int z = 0; z < 2; ++z) {
                float a = oa[hh][d][z];
                a += __shfl_xor(a, 8); a += __shfl_xor(a, 16); a += __shfl_xor(a, 32);
                oa[hh][d][z] = a;
              }
          if (ks == 0) {
#pragma unroll
            for (int hh = 0; hh < 4; ++hh) {
              u32x4 pk = {pack_bf16(oa[hh][0][0], oa[hh][0][1]), pack_bf16(oa[hh][1][0], oa[hh][1][1]), pack_bf16(oa[hh][2][0], oa[hh][2][1]), pack_bf16(oa[hh][3][0], oa[hh][3][1])};
              *(u32x4*)(RO + (size_t)tok * 1024 + (g * 4 + hh) * 64 + 8 * dc) = pk;
            }
          }
        }
      }
    }
  } break;
  default: break;
  }
}

#define XB_TMO      128
#define XB_XCNT(j)  (256  + 64 * (j))
#define XB_XSUB(j)  (1280 + 64 * (j))
#define XB_XGEN(j)  (2304 + 64 * (j))
#define XB_TOP      3328
#define XB_TOPGEN   3392
#define XCD_BAR_WORDS 3456
#define XB_SPIN_CAP (1u << 20)
#define LAS __attribute__((address_space(3)))
DI unsigned xb_ld(unsigned* p)              { return __hip_atomic_load(p, __ATOMIC_RELAXED, __HIP_MEMORY_SCOPE_AGENT); }
DI unsigned xb_add(unsigned* p, unsigned v) { return __hip_atomic_fetch_add(p, v, __ATOMIC_RELAXED, __HIP_MEMORY_SCOPE_AGENT); }
DI unsigned xb_xcc_id() { return (unsigned)__builtin_amdgcn_s_getreg((3 << 11) | 20) & 0xFu; }
#define XB_SPIN(cond, bar) do { unsigned _sp = 0; while (cond) { __builtin_amdgcn_s_sleep(1); \
    if ((++_sp & 255u) == 0u) { if (xb_ld(&(bar)[XB_TMO])) break; if (_sp > XB_SPIN_CAP) { atomicAdd(&(bar)[XB_TMO], 1u); break; } } } } while (0)
struct XcdBarrier { unsigned* bar; unsigned x; volatile LAS unsigned* st; };
DI XcdBarrier xcd_barrier_post(unsigned* bar, volatile LAS unsigned* st) {
  XcdBarrier b; b.bar = bar; b.x = xb_xcc_id(); b.st = st;
  if (threadIdx.x == 0) (void)xb_add(&bar[XB_XCNT(b.x)], 1u);
  return b;
}
DI void xcd_barrier_complete(unsigned* bar, unsigned x, unsigned& nloc, unsigned& nx) {
  const unsigned G = gridDim.x * gridDim.y * gridDim.z;
  unsigned sum, cnt, mine, sp = 0u;
  for (;;) {
    sum = 0u; cnt = 0u; mine = 0u;
#pragma unroll
    for (unsigned j = 0; j < 16; ++j) { const unsigned c = xb_ld(&bar[XB_XCNT(j)]); sum += c; cnt += (c > 0u) ? 1u : 0u; mine = (j == x) ? c : mine; }
    if (sum == G) break;
    __builtin_amdgcn_s_sleep(1);
    if ((++sp & 255u) == 0u) { if (xb_ld(&bar[XB_TMO])) break; if (sp > XB_SPIN_CAP) { atomicAdd(&bar[XB_TMO], 1u); break; } }
  }
  nloc = mine > 0u ? mine : 1u; nx = cnt > 0u ? cnt : 1u;
}
DI void xcd_barrier(const XcdBarrier& b) {
  asm volatile("s_waitcnt vmcnt(0)" ::: "memory");
  __syncthreads();
  if (threadIdx.x == 0) {
    unsigned* bar = b.bar;
    __builtin_amdgcn_s_waitcnt(0);
    unsigned nloc = b.st[0], nx = b.st[1];
    if (nloc == 0u) { xcd_barrier_complete(bar, b.x, nloc, nx); b.st[0] = nloc; b.st[1] = nx; }
    const unsigned old = xb_add(&bar[XB_XSUB(b.x)], 1u);
    const unsigned gen = old / nloc;
    if (old + 1u == (gen + 1u) * nloc) {
      __builtin_amdgcn_fence(__ATOMIC_RELEASE, "agent");
      asm volatile("s_waitcnt vmcnt(0)" ::: "memory");
      const unsigned og = xb_add(&bar[XB_TOP], 1u);
      const unsigned tg = og / nx;
      if (og + 1u == (tg + 1u) * nx) xb_add(&bar[XB_TOPGEN], 1u);
      else XB_SPIN(xb_ld(&bar[XB_TOPGEN]) == tg, bar);
      __builtin_amdgcn_fence(__ATOMIC_ACQUIRE, "agent");
      xb_add(&bar[XB_XGEN(b.x)], 1u);
      asm volatile("s_waitcnt vmcnt(0)" ::: "memory");
    } else {
      XB_SPIN(xb_ld(&bar[XB_XGEN(b.x)]) == gen, bar);
      __builtin_amdgcn_fence(__ATOMIC_ACQUIRE, "agent");
      asm volatile("s_waitcnt vmcnt(0)" ::: "memory");
    }
  }
  __syncthreads();
}

DI void decode_phase(int ph, int& kind, int& layer) {
  if (ph == 0) { kind = PH_PRO; layer = 0; return; }
  int p = ph - 1;
  if (p < 13) layer = 0; else if (p < 23) { layer = 1; p -= 13; } else if (p < 36) { layer = 2; p -= 23; } else { layer = 3; p -= 36; }
  const int nmix = (layer & 1) ? 3 : 6;
  if (p < nmix) { kind = ((layer & 1) ? PH_O1 : PH_E1) + p; return; }
  const int q = p - nmix;
  kind = q < 5 ? PH_MIXO + q : (q == 5 ? PH_P3B : PH_G2);
}

constexpr size_t MS_BAR = 7 * MiB;
__global__ void __launch_bounds__(256, 2) megakernel(Params P) {
  __shared__ __attribute__((aligned(16))) char lds[65536];
  __shared__ uint4 xb_words;
  if (threadIdx.x == 0) xb_words = make_uint4(0u, 0u, 0u, 0u);
  __syncthreads();
  XcdBarrier xb = xcd_barrier_post((unsigned*)(P.ws + OFF_MISC + MS_BAR), (volatile LAS unsigned*)&xb_words);
  for (int ph = P.ph0; ph < P.ph1; ++ph) {
    int kind, layer;
    decode_phase(ph, kind, layer);
#ifdef ONLY_PHASE
    kind = ONLY_PHASE;
#endif
#ifdef DUP_MASK
    if ((DUP_MASK >> kind) & 1) {
#ifndef DUP_NOP
      run_phase(P, kind, layer, lds, true);
#endif
      xcd_barrier(xb);
    }
#endif
    run_phase(P, kind, layer, lds, false);
    if (ph + 1 < P.ph1) {
      if (ph == P.ph0) cg::this_grid().sync();
      else xcd_barrier(xb);
    }
  }
}

extern "C" void kernel_launch(void* const* d_in, const int* in_sizes, int n_in, void* d_out, int out_size, void* d_ws,
                              size_t ws_size, hipStream_t stream) {
  static int grid_blocks = 0;
  const int nph = 47;
  if (!grid_blocks) {
    int dev = 0, cus = 0, per_cu = 0;
    hipGetDevice(&dev);
    hipDeviceGetAttribute(&cus, hipDeviceAttributeMultiprocessorCount, dev);
    hipOccupancyMaxActiveBlocksPerMultiprocessor(&per_cu, megakernel, 256, 0);
    if (per_cu > 2) per_cu = 2;
    if (per_cu < 1) per_cu = 1;
    grid_blocks = cus * per_cu;
    if (grid_blocks > 512) grid_blocks = 512;
    grid_blocks &= ~7;
  }
  Params P{};
  const float** fp = (const float**)&P;
  (void)fp;
  P.x = (const float*)d_in[0]; P.p = (const float*)d_in[1]; P.pos = (const int*)d_in[2]; P.rel_bias = (const float*)d_in[3];
  P.ev_w_in = (const float*)d_in[4]; P.ev_w_uq = (const float*)d_in[5]; P.ev_w_ukv = (const float*)d_in[6];
  P.ev_q_norm = (const float*)d_in[7]; P.ev_kv_norm = (const float*)d_in[8]; P.lq1 = (const float*)d_in[9];
  P.lk1 = (const float*)d_in[10]; P.lq2 = (const float*)d_in[11]; P.lk2 = (const float*)d_in[12];
  P.ev_subln = (const float*)d_in[13]; P.ev_w_o = (const float*)d_in[14]; P.od_w_in = (const float*)d_in[15];
  P.od_w_o = (const float*)d_in[16]; P.ln1_g = (const float*)d_in[17]; P.ln1_b = (const float*)d_in[18];
  P.ln2_g = (const float*)d_in[19]; P.ln2_b = (const float*)d_in[20]; P.peer_w_q = (const float*)d_in[21];
  P.peer_k1 = (const float*)d_in[22]; P.peer_k2 = (const float*)d_in[23]; P.peer_u = (const float*)d_in[24];
  P.peer_v = (const float*)d_in[25]; P.ple_w = (const float*)d_in[26]; P.ple_gate_w = (const float*)d_in[27];
  P.ple_gate_b = (const float*)d_in[28];
  P.out = (float*)d_out; P.ws = (char*)d_ws;
#if MULTI_LAUNCH
  for (int ph = 0; ph < nph; ++ph) {
    P.ph0 = ph; P.ph1 = ph + 1;
    hipLaunchKernelGGL(megakernel, dim3(grid_blocks), dim3(256), 0, stream, P);
  }
#else
  P.ph0 = 0; P.ph1 = nph;
  hipMemsetAsync((char*)d_ws + OFF_MISC + MS_BAR, 0, XCD_BAR_WORDS * 4, stream);
  void* args[] = {&P};
  hipError_t e = hipLaunchCooperativeKernel((void*)megakernel, dim3(grid_blocks), dim3(256), args, 0, stream);
  if (e != hipSuccess) fprintf(stderr, "cooperative launch failed: %s (grid %d)\n", hipGetErrorString(e), grid_blocks);
#endif
}
```

```cpp
#include <hip/hip_runtime.h>
#include <hip/hip_cooperative_groups.h>
#include <stdint.h>
#include <cstdio>
namespace cg = cooperative_groups;

#ifndef MULTI_LAUNCH
#define MULTI_LAUNCH 0
#endif

typedef unsigned short bf16_t;
typedef __attribute__((ext_vector_type(8))) short bf16x8;
typedef __attribute__((ext_vector_type(16))) float f32x16;
typedef __attribute__((ext_vector_type(4))) float f32x4;
typedef __attribute__((ext_vector_type(2))) float f32x2;
typedef __attribute__((ext_vector_type(4))) unsigned u32x4;
typedef __attribute__((ext_vector_type(2))) unsigned u32x2;
typedef __attribute__((ext_vector_type(2))) __bf16 bf16x2v;

#define DI __device__ __forceinline__

constexpr int T_ = 32768, S_ = 4096;
constexpr float DN_ALPHA = 1.6817928305074290f;
constexpr float L2E = 1.4426950408889634f;
constexpr int NE = 2432;
constexpr int NO = 2688;

constexpr size_t MiB = 1024ull * 1024ull;
constexpr size_t OFF_TABU = 0, OFF_TABV = 32 * MiB, OFF_W = 64 * MiB, OFF_H = 128 * MiB, OFF_HBA = 256 * MiB,
                 OFF_HBB = 320 * MiB, OFF_RA = 384 * MiB, OFF_RB = 576 * MiB, OFF_RO = 736 * MiB, OFF_OD = 800 * MiB,
                 OFF_PK = 928 * MiB, OFF_MISC = 960 * MiB;
constexpr size_t RB_QA = 0, RB_KN = 48 * MiB, RB_VTA = 80 * MiB, RB_VTD = 112 * MiB;
constexpr size_t MS_CS = 0  , MS_LUTB = 4 * MiB  , MS_LUTC = 4 * MiB + 32768  ,
                 MS_PMM = 4 * MiB + 98304  , MS_LAM = 4 * MiB + 110592, MS_RSQ = 5 * MiB, MS_RSKV = 5 * MiB + 131072 * 2;
constexpr size_t WE_IN = 0, WE_UQ = 2490368, WE_UKV = WE_UQ + 393216, WE_O = WE_UKV + 262144, WE_SZ = 4194304;
constexpr size_t WO_BASE = 2 * WE_SZ, WO_IN = 0, WO_O = 2752512, WO_SZ = 3801088;
constexpr size_t WL_BASE = WO_BASE + 2 * WO_SZ, WL_Q = 0, WL_K1 = 2097152, WL_K2 = WL_K1 + 16384, WL_G = WL_K2 + 16384,
                 WL_PLE = WL_G + 1048576, WL_SZ = 3440640;

struct Params {
  const float *x, *p; const int* pos; const float* rel_bias;
  const float *ev_w_in, *ev_w_uq, *ev_w_ukv, *ev_q_norm, *ev_kv_norm, *lq1, *lk1, *lq2, *lk2, *ev_subln, *ev_w_o;
  const float *od_w_in, *od_w_o, *ln1_g, *ln1_b, *ln2_g, *ln2_b, *peer_w_q, *peer_k1, *peer_k2, *peer_u, *peer_v,
      *ple_w, *ple_gate_w, *ple_gate_b;
  float* out; char* ws; int ph0, ph1;
};

DI unsigned pack_bf16(float a, float b) {
  f32x2 v = {a, b};
  bf16x2v r = __builtin_convertvector(v, bf16x2v);
  return __builtin_bit_cast(unsigned, r);
}
DI bf16_t f2bf(float a) { return (bf16_t)(pack_bf16(a, 0.f) & 0xffffu); }
DI float bf_lo(unsigned u) { return __uint_as_float(u << 16); }
DI float bf_hi(unsigned u) { return __uint_as_float(u & 0xffff0000u); }
DI float bf2f(bf16_t x) { return __uint_as_float(((unsigned)x) << 16); }
DI float dot2(unsigned a, unsigned b, float c) {
  return __builtin_amdgcn_fdot2_f32_bf16(__builtin_bit_cast(bf16x2v, a), __builtin_bit_cast(bf16x2v, b), c, false);
}
DI float wave_sum(float v) {
#pragma unroll
  for (int o = 32; o >= 1; o >>= 1) v += __shfl_xor(v, o);
  return v;
}
DI float wave_max(float v) {
#pragma unroll
  for (int o = 32; o >= 1; o >>= 1) v = fmaxf(v, __shfl_xor(v, o));
  return v;
}
DI float row16_sum(float x) {
  x += __builtin_bit_cast(float, __builtin_amdgcn_update_dpp(0, __builtin_bit_cast(int, x), 0xB1, 0xf, 0xf, true));
  x += __builtin_bit_cast(float, __builtin_amdgcn_update_dpp(0, __builtin_bit_cast(int, x), 0x4E, 0xf, 0xf, true));
  x += __builtin_bit_cast(float, __builtin_amdgcn_update_dpp(0, __builtin_bit_cast(int, x), 0x141, 0xf, 0xf, true));
  x += __builtin_bit_cast(float, __builtin_amdgcn_update_dpp(0, __builtin_bit_cast(int, x), 0x140, 0xf, 0xf, true));
  return x;
}
DI f32x16 mfma32(bf16x8 a, bf16x8 b, f32x16 c) { return __builtin_amdgcn_mfma_f32_32x32x16_bf16(a, b, c, 0, 0, 0); }
DI f32x4 mfma16(bf16x8 a, bf16x8 b, f32x4 c) { return __builtin_amdgcn_mfma_f32_16x16x32_bf16(a, b, c, 0, 0, 0); }
DI int crow(int i, int h) { return (i & 3) + 8 * (i >> 2) + 4 * h; }

template <int WM, bool SYNC_EPI = false, int EXP = 0, class Epi>
DI void gemm_tile(const bf16_t* __restrict__ A, int lda, const bf16_t* __restrict__ Bt, int K, int m0, int n0,
                  char* lds, Epi& epi) {
  int tid_ = threadIdx.x; asm volatile("" : "+v"(tid_));
  const int tid = tid_, lane = tid & 63, w = tid >> 6, wm = w >> 1, wn = w & 1, hh = lane >> 5, l31 = lane & 31;
  constexpr int BM = 64 * WM;
  constexpr int NA = BM / 32;
  bf16_t* As = (bf16_t*)lds;
  bf16_t* Bs = As + BM * 72;
  f32x16 acc[WM][2];
#pragma unroll
  for (int a = 0; a < WM; ++a)
#pragma unroll
    for (int b = 0; b < 2; ++b)
#pragma unroll
      for (int i = 0; i < 16; ++i) acc[a][b][i] = 0.f;
  const int nk = K >> 6;
  u32x4 ra[NA], rb[4];
  const int prow = tid >> 3, pc = (tid & 7) * 8;
  const bf16_t* ag = A + (size_t)(m0 + prow) * lda + pc;
  const bf16_t* bg = Bt + (size_t)(n0 + prow) * K + pc;
  auto gload = [&](int kt) {
#pragma unroll
    for (int i = 0; i < NA; ++i) ra[i] = *(const u32x4*)(ag + (size_t)(32 * i) * lda + kt * 64);
#pragma unroll
    for (int i = 0; i < 4; ++i) rb[i] = *(const u32x4*)(bg + (size_t)(32 * i) * K + kt * 64);
  };
  auto lstore = [&]() {
#pragma unroll
    for (int i = 0; i < NA; ++i) *(u32x4*)(As + (prow + 32 * i) * 72 + pc) = ra[i];
#pragma unroll
    for (int i = 0; i < 4; ++i) *(u32x4*)(Bs + (prow + 32 * i) * 72 + pc) = rb[i];
  };
  gload(0);
  for (int kt = 0; kt < nk; ++kt) {
    if (EXP != 5) __syncthreads();
    if (EXP != 3 || kt == 0) lstore();
    if (EXP != 5) __syncthreads();
    if (EXP != 2 && EXP != 3) { if (kt + 1 < nk) gload(kt + 1); }
#pragma unroll
    for (int s = 0; s < 4; ++s) {
      if (EXP == 4) break;
      bf16x8 af[WM], bfr[2];
#pragma unroll
      for (int mt = 0; mt < WM; ++mt)
        af[mt] = *(const bf16x8*)(As + (32 * WM * wm + 32 * mt + l31) * 72 + s * 16 + hh * 8);
#pragma unroll
      for (int nt = 0; nt < 2; ++nt)
        bfr[nt] = *(const bf16x8*)(Bs + (64 * wn + 32 * nt + l31) * 72 + s * 16 + hh * 8);
#pragma unroll
      for (int mt = 0; mt < WM; ++mt)
#pragma unroll
        for (int nt = 0; nt < 2; ++nt) acc[mt][nt] = mfma32(af[mt], bfr[nt], acc[mt][nt]);
    }
  }
  if (SYNC_EPI) __syncthreads();
  if (EXP == 1) { if (acc[0][0][0] != 12345.678f) return; }
#pragma unroll
  for (int mt = 0; mt < WM; ++mt)
#pragma unroll
    for (int nt = 0; nt < 2; ++nt) epi(m0 + 32 * WM * wm + 32 * mt, n0 + 64 * wn + 32 * nt, acc[mt][nt], lane);
}

DI void store_vT(bf16_t* vT, int head, int dim, int r, float v0, float v1, float v2, float v3) {
  int b = r >> 12, s = r & 4095;
  u32x2 pk = {pack_bf16(v0, v1), pack_bf16(v2, v3)};
  *(u32x2*)(vT + ((size_t)((b * 8 + head) * 64 + dim)) * S_ + s) = pk;
}

struct EpiEvenProj {
  bf16_t* proj; bf16_t* vTd;
  DI void operator()(int rb, int cb, const f32x16& a, int lane) const {
    int c = cb + (lane & 31), h = lane >> 5;
    if (cb < 1824) {
#pragma unroll
      for (int i = 0; i < 16; ++i) proj[(size_t)(rb + crow(i, h)) * NE + c] = f2bf(a[i]);
    } else if (cb < 2336) {
      int cc = c - 1824, head = cc >> 6, dim = cc & 63;
#pragma unroll
      for (int g = 0; g < 4; ++g) store_vT(vTd, head, dim, rb + 8 * g + 4 * h, a[4 * g], a[4 * g + 1], a[4 * g + 2], a[4 * g + 3]);
    }
  }
};
struct EpiRowScaleBf16 {
  bf16_t* out; int ldo; const float* rs;
  DI void operator()(int rb, int cb, const f32x16& a, int lane) const {
    int c = cb + (lane & 31), h = lane >> 5;
#pragma unroll
    for (int i = 0; i < 16; ++i) { int r = rb + crow(i, h); out[(size_t)r * ldo + c] = f2bf(a[i] * rs[r]); }
  }
};
struct EpiKV {
  bf16_t* kn; bf16_t* vTa; const float* rs;
  DI void operator()(int rb, int cb, const f32x16& a, int lane) const {
    int c = cb + (lane & 31), h = lane >> 5, head = c >> 7, d = c & 127;
    if (d < 64) {
#pragma unroll
      for (int i = 0; i < 16; ++i) { int r = rb + crow(i, h); kn[(size_t)r * 512 + head * 64 + d] = f2bf(a[i] * rs[r]); }
    } else {
#pragma unroll
      for (int g = 0; g < 4; ++g) {
        int r = rb + 8 * g + 4 * h;
        store_vT(vTa, head, d - 64, r, a[4 * g] * rs[r], a[4 * g + 1] * rs[r + 1], a[4 * g + 2] * rs[r + 2], a[4 * g + 3] * rs[r + 3]);
      }
    }
  }
};
struct EpiBf16 {
  bf16_t* out; int ldo; int nvalid;
  DI void operator()(int rb, int cb, const f32x16& a, int lane) const {
    int c = cb + (lane & 31), h = lane >> 5;
    if (cb < nvalid) {
#pragma unroll
      for (int i = 0; i < 16; ++i) out[(size_t)(rb + crow(i, h)) * ldo + c] = f2bf(a[i]);
    }
  }
};
struct EpiResid {
  bf16_t* y; const float* hres; const bf16_t* hresb;
  DI void operator()(int rb, int cb, const f32x16& a, int lane) const {
    int c = cb + (lane & 31), h = lane >> 5;
    if (hres) {
#pragma unroll
      for (int i = 0; i < 16; ++i) { size_t o = (size_t)(rb + crow(i, h)) * 1024 + c; y[o] = f2bf(DN_ALPHA * hres[o] + a[i]); }
    } else {
#pragma unroll
      for (int i = 0; i < 16; ++i) { size_t o = (size_t)(rb + crow(i, h)) * 1024 + c; y[o] = f2bf(DN_ALPHA * bf2f(hresb[o]) + a[i]); }
    }
  }
};
struct EpiGate {
  const bf16_t* hin; float* outp; bf16_t* hb; const bf16_t* pw; const float* bg;
  DI void operator()(int rb, int cb, const f32x16& a, int lane) const {
    int c = cb + (lane & 31), h = lane >> 5;
    float bb = bg[c];
#pragma unroll
    for (int i = 0; i < 16; ++i) {
      size_t o = (size_t)(rb + crow(i, h)) * 1024 + c;
      float g = 1.f / (1.f + __expf(-(a[i] + bb)));
      float hn = bf2f(hin[o]) + g * bf2f(pw[o]);
      if (outp) outp[o] = hn;
      hb[o] = f2bf(hn);
    }
  }
};
struct EpiLds {
  float* s;
  DI void operator()(int rb, int cb, const f32x16& a, int lane) const {
    int c = (cb & 127) + (lane & 31), h = lane >> 5;
#pragma unroll
    for (int i = 0; i < 16; ++i) { int r = (rb & 127) + crow(i, h); s[r * 128 + ((c + r) & 127)] = a[i]; }
  }
};

DI void conv_item(const float* __restrict__ src, bf16_t* __restrict__ dst, int item) {
  int tid_ = threadIdx.x; asm volatile("" : "+v"(tid_));
  size_t o = (size_t)item * 2048 + tid_ * 8;
  f32x4 v0 = *(const f32x4*)(src + o), v1 = *(const f32x4*)(src + o + 4);
  u32x4 r = {pack_bf16(v0[0], v0[1]), pack_bf16(v0[2], v0[3]), pack_bf16(v1[0], v1[1]), pack_bf16(v1[2], v1[3])};
  *(u32x4*)(dst + o) = r;
}
DI void convfp8_item(const float* __restrict__ src, unsigned char* __restrict__ dst, float* __restrict__ inv_scale, int item) {
  int tid_ = threadIdx.x; asm volatile("" : "+v"(tid_));
  const int lane = tid_ & 63, row = item * 4 + (tid_ >> 6);
  const float* r = src + (size_t)row * 1024 + 16 * lane;
  f32x4 v[4];
  float am = 0.f;
#pragma unroll
  for (int k = 0; k < 4; ++k) {
    v[k] = *(const f32x4*)(r + 4 * k);
    am = fmaxf(am, fmaxf(fmaxf(fabsf(v[k][0]), fabsf(v[k][1])), fmaxf(fabsf(v[k][2]), fabsf(v[k][3]))));
  }
  am = wave_max(am);
  const float sc = am > 0.f ? 224.f / am : 1.f;
  u32x4 o;
#pragma unroll
  for (int k = 0; k < 4; ++k) {
    int p = 0;
    p = __builtin_amdgcn_cvt_pk_fp8_f32(v[k][0] * sc, v[k][1] * sc, p, false);
    p = __builtin_amdgcn_cvt_pk_fp8_f32(v[k][2] * sc, v[k][3] * sc, p, true);
    o[k] = (unsigned)p;
  }
  *(u32x4*)(dst + (size_t)row * 1024 + 16 * lane) = o;
  if (lane == 0) inv_scale[row] = 1.f / sc;
}
DI void tconv_item(const float* __restrict__ src, int K, int N, int Npad, bf16_t* __restrict__ dst,
                   const float* __restrict__ g, int item, char* lds) {
  float* tile = (float*)lds;
  int tid_ = threadIdx.x; asm volatile("" : "+v"(tid_));
  const int tid = tid_;
  const int tn = Npad >> 6;
  const int k0 = (item / tn) * 64, n0 = (item % tn) * 64;
#pragma unroll
  for (int i = 0; i < 4; ++i) {
    int r = (tid >> 4) + 16 * i, c4 = (tid & 15) * 4;
    f32x4 v = {0.f, 0.f, 0.f, 0.f};
    if (n0 + c4 < N) v = *(const f32x4*)(src + (size_t)(k0 + r) * N + n0 + c4);
    float sc = g ? g[k0 + r] : 1.f;
#pragma unroll
    for (int e = 0; e < 4; ++e) tile[r * 65 + c4 + e] = v[e] * sc;
  }
  __syncthreads();
  {
    int nl = tid >> 2, kp = (tid & 3) * 16;
    unsigned pk[8];
#pragma unroll
    for (int e = 0; e < 8; ++e) pk[e] = pack_bf16(tile[(kp + 2 * e) * 65 + nl], tile[(kp + 2 * e + 1) * 65 + nl]);
    bf16_t* d = dst + (size_t)(n0 + nl) * K + k0 + kp;
    u32x4 a = {pk[0], pk[1], pk[2], pk[3]}, b = {pk[4], pk[5], pk[6], pk[7]};
    *(u32x4*)d = a;
    *(u32x4*)(d + 8) = b;
  }
  __syncthreads();
}

DI int t5_bucket(int rel) {
  int n = rel < 0 ? -rel : rel;
  float fn = (float)(n > 1 ? n : 1);
  int large = 8 + (int)(logf(fn / 8.f) / 3.4657359027997265f * 8.f);
  large = large < 15 ? large : 15;
  return (rel > 0 ? 16 : 0) + (n < 8 ? n : large);
}

template <int DQK, bool BIAS>
DI void attn_item(const bf16_t* __restrict__ Qp, int qs, const bf16_t* __restrict__ K1p, int k1s,
                  const bf16_t* __restrict__ K2p, int k2s, const bf16_t* __restrict__ vT, const int* __restrict__ posb,
                  const float* __restrict__ lut, const int* __restrict__ pmm, int tok0  , int qt, float scale_l2e,
                  char* lds, bf16_t* ob, float* of, int ostride, const float* __restrict__ cst = nullptr) {
  constexpr int KST = DQK + 8;
  constexpr int NPC = DQK / 8;
  constexpr int NP = DQK / 32;
  constexpr int NS = DQK / 16;
  int tid_ = threadIdx.x; asm volatile("" : "+v"(tid_));
  const int tid = tid_, lane = tid & 63, w = tid >> 6, hh = lane >> 5, l31 = lane & 31;
  bf16_t* Ks = (bf16_t*)lds;
  bf16_t* Vs = (bf16_t*)(lds + 13312);
  int* posk = (int*)(lds + 22016);
  float* lut_s = (float*)(lds + 22272);
  const int qrow = 128 * qt + 32 * w + l31;
  const int ntile = 2 * qt + 2;
  const int mylast = 2 * qt + (w >> 1);
  bf16x8 qf[NS];
#pragma unroll
  for (int s = 0; s < NS; ++s) qf[s] = *(const bf16x8*)(Qp + (size_t)(tok0 + qrow) * qs + 16 * s + 8 * hh);
  if (DQK == 96) {
    const float* cp = cst + ((size_t)(tok0 + qrow) * 16 + 8 * hh) * 2;
    f32x4 cv[4];
#pragma unroll
    for (int k = 0; k < 4; ++k) cv[k] = *(const f32x4*)(cp + 4 * k);
#pragma unroll
    for (int j = 0; j < 8; ++j) {
      const float cs = cv[j >> 1][(2 * j) & 3], sn = cv[j >> 1][(2 * j + 1) & 3];
      const float x1 = bf2f((bf16_t)qf[NS - 2][j]), x2 = bf2f((bf16_t)qf[NS - 1][j]);
      qf[NS - 2][j] = (short)f2bf(x1 * cs - x2 * sn);
      qf[NS - 1][j] = (short)f2bf(x2 * cs + x1 * sn);
    }
  }
  int posq = 0, qmin = 0;
  if (BIAS) {
    posq = posb[qrow];
    qmin = posq;
#pragma unroll
    for (int o = 16; o >= 1; o >>= 1) { int t = __shfl_xor(qmin, o); qmin = t < qmin ? t : qmin; }
    __syncthreads();
    for (int i = tid; i < 513; i += 256) lut_s[i] = lut[i];
  }
  f32x16 oacc[2];
#pragma unroll
  for (int i = 0; i < 16; ++i) { oacc[0][i] = 0.f; oacc[1][i] = 0.f; }
  float mrun = -INFINITY, lrun = 0.f;
  u32x4 kr[NP], vr[2]; int pr = 0;
  auto gload = [&](int kt) {
    const int key0 = kt * 64;
#pragma unroll
    for (int i = 0; i < NP; ++i) {
      int p = tid + 256 * i, row = p / NPC, c = p % NPC;
      const bf16_t* src = (DQK == 32 || c < 8) ? K1p + (size_t)(tok0 + key0 + row) * k1s + 8 * c
                                                : K2p + (size_t)(tok0 + key0 + row) * k2s + 8 * (c - 8);
      kr[i] = *(const u32x4*)src;
    }
#pragma unroll
    for (int i = 0; i < 2; ++i) {
      int p = tid + 256 * i, d = p >> 3, c = p & 7;
      vr[i] = *(const u32x4*)(vT + (size_t)d * S_ + key0 + 8 * c);
    }
    if (BIAS && tid < 64) pr = posb[key0 + tid];
  };
  auto lstore = [&]() {
#pragma unroll
    for (int i = 0; i < NP; ++i) {
      int p = tid + 256 * i, row = p / NPC, c = p % NPC;
      *(u32x4*)(Ks + row * KST + 8 * c) = kr[i];
    }
#pragma unroll
    for (int i = 0; i < 2; ++i) {
      int p = tid + 256 * i, d = p >> 3, c = p & 7;
      u32x2 lo = {vr[i][0], vr[i][1]}, hi = {vr[i][2], vr[i][3]};
      *(u32x2*)(Vs + d * 68 + 8 * c) = lo;
      *(u32x2*)(Vs + d * 68 + 8 * c + 4) = hi;
    }
    if (BIAS && tid < 64) posk[tid] = pr;
  };
  gload(0);
  for (int kt = 0; kt < ntile; ++kt) {
    __syncthreads();
    lstore();
    __syncthreads();
    if (kt + 1 < ntile) gload(kt + 1);
    if (kt <= mylast) {
      f32x16 s0, s1;
#pragma unroll
      for (int i = 0; i < 16; ++i) { s0[i] = 0.f; s1[i] = 0.f; }
#pragma unroll
      for (int s = 0; s < NS; ++s) {
        bf16x8 k0 = *(const bf16x8*)(Ks + l31 * KST + 16 * s + 8 * hh);
        bf16x8 k1 = *(const bf16x8*)(Ks + (32 + l31) * KST + 16 * s + 8 * hh);
        s0 = mfma32(k0, qf[s], s0);
        s1 = mfma32(k1, qf[s], s1);
      }
      bool folded = true;
      float cst = 0.f;
      if (BIAS) {
        const int kmax = pmm[kt * 2 + 1];
        if (qmin - kmax >= 256) {
          cst = lut_s[0];
        } else {
          folded = false;
#pragma unroll
          for (int i = 0; i < 16; ++i) {
            int kk = crow(i, hh);
            int r0 = posk[kk] - posq, r1 = posk[kk + 32] - posq;
            r0 = min(max(r0, -256), 256) + 256;
            r1 = min(max(r1, -256), 256) + 256;
            s0[i] = fmaf(s0[i], scale_l2e, lut_s[r0]);
            s1[i] = fmaf(s1[i], scale_l2e, lut_s[r1]);
          }
        }
      }
      float mx = s0[0];
#pragma unroll
      for (int i = 0; i < 16; ++i) { mx = fmaxf(mx, s0[i]); mx = fmaxf(mx, s1[i]); }
      mx = fmaxf(mx, __shfl_xor(mx, 32));
      if (folded) mx = fmaf(mx, scale_l2e, cst);
      const float mnew = fmaxf(mrun, mx);
      const float alpha = __builtin_amdgcn_exp2f(mrun - mnew);
      mrun = mnew;
      float ps = 0.f;
      const float fsc = folded ? scale_l2e : 1.f;
      const float fof = folded ? cst - mnew : -mnew;
#pragma unroll
      for (int i = 0; i < 16; ++i) {
        s0[i] = __builtin_amdgcn_exp2f(fmaf(s0[i], fsc, fof));
        s1[i] = __builtin_amdgcn_exp2f(fmaf(s1[i], fsc, fof));
        ps += s0[i] + s1[i];
      }
      lrun = lrun * alpha + ps;
#pragma unroll
      for (int i = 0; i < 16; ++i) { oacc[0][i] *= alpha; oacc[1][i] *= alpha; }
#pragma unroll
      for (int st = 0; st < 2; ++st) {
#pragma unroll
        for (int s = 0; s < 2; ++s) {
          u32x4 pp;
          if (st == 0) {
            pp[0] = pack_bf16(s0[8 * s + 0], s0[8 * s + 1]); pp[1] = pack_bf16(s0[8 * s + 2], s0[8 * s + 3]);
            pp[2] = pack_bf16(s0[8 * s + 4], s0[8 * s + 5]); pp[3] = pack_bf16(s0[8 * s + 6], s0[8 * s + 7]);
          } else {
            pp[0] = pack_bf16(s1[8 * s + 0], s1[8 * s + 1]); pp[1] = pack_bf16(s1[8 * s + 2], s1[8 * s + 3]);
            pp[2] = pack_bf16(s1[8 * s + 4], s1[8 * s + 5]); pp[3] = pack_bf16(s1[8 * s + 6], s1[8 * s + 7]);
          }
          bf16x8 pf = __builtin_bit_cast(bf16x8, pp);
#pragma unroll
          for (int mt = 0; mt < 2; ++mt) {
            const bf16_t* vp = Vs + (32 * mt + l31) * 68 + 32 * st + 16 * s + 4 * hh;
            u32x2 a = *(const u32x2*)vp, b = *(const u32x2*)(vp + 8);
            u32x4 vv = {a[0], a[1], b[0], b[1]};
            oacc[mt] = mfma32(__builtin_bit_cast(bf16x8, vv), pf, oacc[mt]);
          }
        }
      }
    }
  }
  const float ltot = lrun + __shfl_xor(lrun, 32);
  const float inv = 1.f / ltot;
  const size_t orow = (size_t)(tok0 + qrow) * ostride;
#pragma unroll
  for (int mt = 0; mt < 2; ++mt)
#pragma unroll
    for (int g = 0; g < 4; ++g) {
      int d = 32 * mt + 8 * g + 4 * hh;
      float v0 = oacc[mt][4 * g] * inv, v1 = oacc[mt][4 * g + 1] * inv, v2 = oacc[mt][4 * g + 2] * inv, v3 = oacc[mt][4 * g + 3] * inv;
      if (ob) {
        u32x2 pk = {pack_bf16(v0, v1), pack_bf16(v2, v3)};
        *(u32x2*)(ob + orow + d) = pk;
      } else {
        f32x4 o = {v0, v1, v2, v3};
        *(f32x4*)(of + orow + d) = o;
      }
    }
}

DI void top16_insert(float (&v)[16], int (&id)[16], float x, int xi) {
  if (x > v[15]) {
#pragma unroll
    for (int p = 0; p < 16; ++p) {
      bool gt = x > v[p];
      float tv = gt ? v[p] : x; int ti = gt ? id[p] : xi;
      v[p] = gt ? x : v[p]; id[p] = gt ? xi : id[p];
      x = tv; xi = ti;
    }
  }
}
DI void top16_merge(float (&v)[16], int (&id)[16]) {
  float nv[16]; int ni[16];
#pragma unroll
  for (int i = 0; i < 16; ++i) {
    float pv = __shfl_xor(v[15 - i], 1); int pi = __shfl_xor(id[15 - i], 1);
    bool take = (pv > v[i]) || (pv == v[i] && pi < id[i]);
    nv[i] = take ? pv : v[i]; ni[i] = take ? pi : id[i];
  }
#pragma unroll
  for (int i = 0; i < 16; ++i) { v[i] = nv[i]; id[i] = ni[i]; }
}

DI unsigned mono_key(float f) { unsigned u = __float_as_uint(f); return (u >> 31) ? ~u : (u | 0x80000000u); }
DI float key_val(unsigned k) { return __uint_as_float((k >> 31) ? (k & 0x7fffffffu) : ~k); }
DI void ce_desc(unsigned& a, unsigned& b) { unsigned hi = a > b ? a : b, lo = a > b ? b : a; a = hi; b = lo; }
DI void sort8_desc(unsigned (&k)[8]) {
  ce_desc(k[0], k[1]); ce_desc(k[2], k[3]); ce_desc(k[4], k[5]); ce_desc(k[6], k[7]);
  ce_desc(k[0], k[2]); ce_desc(k[1], k[3]); ce_desc(k[4], k[6]); ce_desc(k[5], k[7]);
  ce_desc(k[1], k[2]); ce_desc(k[5], k[6]);
  ce_desc(k[0], k[4]); ce_desc(k[1], k[5]); ce_desc(k[2], k[6]); ce_desc(k[3], k[7]);
  ce_desc(k[2], k[4]); ce_desc(k[3], k[5]);
  ce_desc(k[1], k[2]); ce_desc(k[3], k[4]); ce_desc(k[5], k[6]);
}
DI void sort4_desc(unsigned (&k)[4]) {
  ce_desc(k[0], k[1]); ce_desc(k[2], k[3]); ce_desc(k[0], k[2]); ce_desc(k[1], k[3]); ce_desc(k[1], k[2]);
}
DI unsigned umax_dpp(unsigned m, int) { return m; }
template <int N>
DI unsigned dpp_top16(unsigned (&k)[N], int j16) {
  unsigned res = 0;
#pragma unroll
  for (int r = 0; r < 16; ++r) {
    unsigned m = k[0], t;
    t = (unsigned)__builtin_amdgcn_update_dpp(0, (int)m, 0xB1, 0xf, 0xf, true); m = m > t ? m : t;
    t = (unsigned)__builtin_amdgcn_update_dpp(0, (int)m, 0x4E, 0xf, 0xf, true); m = m > t ? m : t;
    t = (unsigned)__builtin_amdgcn_update_dpp(0, (int)m, 0x141, 0xf, 0xf, true); m = m > t ? m : t;
    t = (unsigned)__builtin_amdgcn_update_dpp(0, (int)m, 0x140, 0xf, 0xf, true); m = m > t ? m : t;
    const bool win = k[0] == m;
#pragma unroll
    for (int i = 0; i < N - 1; ++i) k[i] = win ? k[i + 1] : k[i];
    k[N - 1] = win ? 0u : k[N - 1];
    res = (j16 == r) ? m : res;
  }
  return res;
}

enum { PH_PRO = 0, PH_E1, PH_E2, PH_E3, PH_E4, PH_E5, PH_E6, PH_MIXO, PH_LN1, PH_P1, PH_P2, PH_P3, PH_G2, PH_O1, PH_O2, PH_O3, PH_P3B };

struct PhaseDesc { int kind; int layer; };

__device__ __forceinline__ void run_phase(const Params& P, int kind, int L, char* lds, bool dry) {
  int tid_ = threadIdx.x, bid_ = blockIdx.x;
  asm volatile("" : "+v"(tid_));
  asm volatile("" : "+s"(bid_));
  const int tid = tid_, lane = tid & 63, w = tid >> 6;
  const int nb = gridDim.x, bid = bid_;
  const int xcd = bid & 7, li = bid >> 3, nloc = nb >> 3;
  char* ws = P.ws;
  bf16_t* Wb = (bf16_t*)(ws + OFF_W);
  unsigned char* tabU = (unsigned char*)(ws + OFF_TABU);
  unsigned char* tabV = (unsigned char*)(ws + OFF_TABU + 16 * MiB);
  float* sclU = (float*)(ws + OFF_MISC + 6 * MiB);
  float* sclV = sclU + 16384;
  float* Hf = (float*)(ws + OFF_H);
  bf16_t* hbA = (bf16_t*)(ws + OFF_HBA);
  bf16_t* hbB = (bf16_t*)(ws + OFF_HBB);
  bf16_t* RA = (bf16_t*)(ws + OFF_RA);
  char* RB = ws + OFF_RB;
  bf16_t* RO = (bf16_t*)(ws + OFF_RO);
  float* OD = (float*)(ws + OFF_OD);
  int* pe_idx = (int*)(ws + OFF_PK);
  float* pe_g = (float*)(ws + OFF_PK + 16 * MiB);
  char* MS = ws + OFF_MISC;
  float* cstab = (float*)(MS + MS_CS);
  float* lutB = (float*)(MS + MS_LUTB);
  float* lutC = (float*)(MS + MS_LUTC);
  int* pmm = (int*)(MS + MS_PMM);
  float* lamv = (float*)(MS + MS_LAM);
  float* rsq = (float*)(MS + MS_RSQ);
  float* rskv = (float*)(MS + MS_RSKV);
  const int j = L >> 1;
  const bf16_t* We = Wb + (size_t)j * WE_SZ;
  const bf16_t* Wo = Wb + WO_BASE + (size_t)j * WO_SZ;
  const bf16_t* Wl = Wb + WL_BASE + (size_t)L * WL_SZ;

  switch (kind) {
  case PH_PRO: {
    {
      int base = 0;
#pragma unroll 1
      for (int job = 0; job < 24; ++job) {
        const float* src; const float* gsc = nullptr; bf16_t* dst; int K, N, Np;
        if (job < 12) {
          const int jj = job / 6, k = job % 6;
          bf16_t* W = Wb + (size_t)jj * WE_SZ;
          bf16_t* W2 = Wb + WO_BASE + (size_t)jj * WO_SZ;
          if (k == 0) { src = P.ev_w_in + (size_t)jj * 1024 * 2336; K = 1024; N = 2336; Np = NE; dst = W + WE_IN; }
          else if (k == 1) { src = P.ev_w_uq + (size_t)jj * 512 * 768; K = 512; N = 768; Np = 768; dst = W + WE_UQ; gsc = P.ev_q_norm + jj * 512; }
          else if (k == 2) { src = P.ev_w_ukv + (size_t)jj * 256 * 1024; K = 256; N = 1024; Np = 1024; dst = W + WE_UKV; gsc = P.ev_kv_norm + jj * 256; }
          else if (k == 3) { src = P.ev_w_o + (size_t)jj * 1024 * 1024; K = 1024; N = 1024; Np = 1024; dst = W + WE_O; }
          else if (k == 4) { src = P.od_w_in + (size_t)jj * 1024 * 2640; K = 1024; N = 2640; Np = NO; dst = W2 + WO_IN; }
          else { src = P.od_w_o + (size_t)jj * 1024 * 1024; K = 1024; N = 1024; Np = 1024; dst = W2 + WO_O; }
        } else {
          const int l = (job - 12) / 3, k = (job - 12) % 3;
          bf16_t* W = Wb + WL_BASE + (size_t)l * WL_SZ;
          if (k == 0) { src = P.peer_w_q + (size_t)l * 1024 * 2048; K = 1024; N = 2048; Np = 2048; dst = W + WL_Q; }
          else if (k == 1) { src = P.ple_gate_w + (size_t)l * 1024 * 1024; K = 1024; N = 1024; Np = 1024; dst = W + WL_G; }
          else { src = P.ple_w + (size_t)l * 256 * 1024; K = 256; N = 1024; Np = 1024; dst = W + WL_PLE; }
        }
        const int n = (K >> 6) * (Np >> 6);
        for (int it = bid - base; it < n; it += nb) if (it >= 0) tconv_item(src, K, N, Np, dst, gsc, it, lds);
        base = (base + n) % nb;
      }
      for (int it = bid; it < 64; it += nb) {
        const int l = it >> 4, k = (it >> 3) & 1, i8 = it & 7;
        bf16_t* W = Wb + WL_BASE + (size_t)l * WL_SZ;
        conv_item((k ? P.peer_k2 : P.peer_k1) + (size_t)l * 16384, W + (k ? WL_K2 : WL_K1), i8);
      }
    }
    for (int it = bid; it < 16384; it += nb) conv_item(P.x, hbB, it);
    for (int it = bid; it < 2048; it += nb) {
      int idx = it * 256 + tid, t = idx >> 4, f = idx & 15;
      float freq = powf(10000.f, -(float)f / 16.f);
      float ang = (float)P.pos[t] * freq;
      float sn, cs;
      sincosf(ang, &sn, &cs);
      cstab[2 * idx] = cs; cstab[2 * idx + 1] = sn;
    }
    if (bid == 0) {
      for (int i = tid; i < 8 * 513; i += 256) { int hd = i / 513, r = i % 513; lutB[hd * 520 + r] = P.rel_bias[t5_bucket(r - 256) * 24 + hd] * L2E; }
      for (int i = tid; i < 16 * 513; i += 256) { int r = i >> 4, hd = i & 15; lutC[r * 16 + hd] = P.rel_bias[t5_bucket(r - 256) * 24 + 8 + hd] * L2E; }
      for (int i = tid; i < 512; i += 256) {
        int mn = 0x7fffffff, mx = -0x7fffffff;
        for (int k = 0; k < 64; ++k) { int v = P.pos[i * 64 + k]; mn = v < mn ? v : mn; mx = v > mx ? v : mx; }
        pmm[2 * i] = mn; pmm[2 * i + 1] = mx;
      }
      if (tid < 2) {
        float a = 0.f, b = 0.f;
        for (int k = 0; k < 32; ++k) { a += P.lq1[tid * 32 + k] * P.lk1[tid * 32 + k]; b += P.lq2[tid * 32 + k] * P.lk2[tid * 32 + k]; }
        float lam_init = 0.8f - 0.6f * expf(-0.3f * (float)(2 * tid));
        lamv[2 * tid] = expf(a) - expf(b) + lam_init;
        lamv[2 * tid + 1] = lam_init;
      }
    }
  } break;

  case PH_E1: {
    EpiEvenProj epi{RA, (bf16_t*)(RB + RB_VTD)};
    const int ntn = NE / 128;
#ifdef GEMM_EXP
    if (dry) {
      EpiEvenProj epd{(bf16_t*)OD, (bf16_t*)OD + 80 * MiB / 2};
      for (int it = bid; it < 128 * ntn; it += nb) gemm_tile<4, false, GEMM_EXP>(hbB, 1024, We + WE_IN, 1024, (it / ntn) * 256, (it % ntn) * 128, lds, epd);
      break;
    }
#endif
    for (int j = li; j < 16 * ntn; j += nloc) gemm_tile<4>(hbB, 1024, We + WE_IN, 1024, (xcd + 8 * (j / ntn)) * 256, (j % ntn) * 128, lds, epi);
  } break;

  case PH_E2: {
    for (int it = bid; it < T_ / 4; it += nb) {
      int t = it * 4 + w;
      const bf16_t* row = RA + (size_t)t * NE;
      u32x4 a = *(const u32x4*)(row + 8 * lane);
      float ss = 0.f;
#pragma unroll
      for (int e = 0; e < 4; ++e) { float lo = bf_lo(a[e]), hi = bf_hi(a[e]); ss += lo * lo + hi * hi; }
      ss = wave_sum(ss);
      u32x2 c = *(const u32x2*)(row + 512 + 4 * lane);
      float s2 = 0.f;
#pragma unroll
      for (int e = 0; e < 2; ++e) { float lo = bf_lo(c[e]), hi = bf_hi(c[e]); s2 += lo * lo + hi * hi; }
      s2 = wave_sum(s2);
      if (lane == 0) { rsq[t] = rsqrtf(ss / 512.f + 1e-6f); rskv[t] = rsqrtf(s2 / 256.f + 1e-6f); }
      if (lane < 16) {
        bf16_t* kr = RA + (size_t)t * NE + 768;
        float x1 = bf2f(kr[lane]), x2 = bf2f(kr[16 + lane]);
        float cs = cstab[(t * 16 + lane) * 2], sn = cstab[(t * 16 + lane) * 2 + 1];
        kr[lane] = f2bf(x1 * cs - x2 * sn);
        kr[16 + lane] = f2bf(x2 * cs + x1 * sn);
      }
    }
  } break;

  case PH_E3: {
    EpiRowScaleBf16 e1{(bf16_t*)(RB + RB_QA), 768, rsq};
    EpiKV e2{(bf16_t*)(RB + RB_KN), (bf16_t*)(RB + RB_VTA), rskv};
    const int n1 = 128 * 6, n2 = 128 * 8;
    int j = li;
    for (; j < 96; j += nloc) gemm_tile<4>(RA, NE, We + WE_UQ, 512, (xcd + 8 * (j / 6)) * 256, (j % 6) * 128, lds, e1);
    for (; j < 96 + 128; j += nloc) { int j2 = j - 96; gemm_tile<4>(RA + 512, NE, We + WE_UKV, 256, (xcd + 8 * (j2 >> 3)) * 256, (j2 & 7) * 128, lds, e2); }
  } break;

  case PH_E4: {
    bf16_t* qa = (bf16_t*)(RB + RB_QA);
    for (int it = bid; it < 16384; it += nb) {
      int idx = it * 256 + tid, t = idx >> 7, hd = (idx >> 4) & 7, f = idx & 15;
      bf16_t* q = qa + (size_t)t * 768 + hd * 96 + 64;
      float x1 = bf2f(q[f]), x2 = bf2f(q[16 + f]);
      float cs = cstab[(t * 16 + f) * 2], sn = cstab[(t * 16 + f) * 2 + 1];
      q[f] = f2bf(x1 * cs - x2 * sn);
      q[16 + f] = f2bf(x2 * cs + x1 * sn);
    }
  } break;

  case PH_E5: {
    const bf16_t* qa = (const bf16_t*)(RB + RB_QA);
    const bf16_t* kn = (const bf16_t*)(RB + RB_KN);
    const bf16_t* vTa = (const bf16_t*)(RB + RB_VTA);
    const bf16_t* vTd = (const bf16_t*)(RB + RB_VTD);
    for (int rr = li >> 5; rr < 24; rr += ((nloc >> 5) > 0 ? (nloc >> 5) : 1)) {
      const int combo = xcd + 8 * rr;
      const int qt = ((rr >> 1) & 1) ? (li & 31) : 31 - (li & 31);
      const int b = combo / 24, u = combo % 24;
      int tok0 = b * S_;
      if (u < 8) {
        attn_item<96, false>(qa + u * 96, 768, kn + u * 64, 512, RA + 768, NE, vTa + (size_t)((b * 8 + u) * 64) * S_,
                             P.pos + tok0, nullptr, pmm + b * 128, tok0, qt, 0.10206207261596577f * L2E, lds,
                             RO + u * 64, nullptr, 1024, cstab);
      } else {
        int hd = (u - 8) >> 1, m = (u - 8) & 1;
        attn_item<32, true>(RA + 800 + hd * 64 + m * 32, NE, RA + 1312 + hd * 64 + m * 32, NE, nullptr, 0,
                            vTd + (size_t)((b * 8 + hd) * 64) * S_, P.pos + tok0, lutB + hd * 520, pmm + b * 128, tok0, qt,
                            0.17677669529663687f * L2E, lds, nullptr, OD + (size_t)m * T_ * 512 + hd * 64, 512);
      }
    }
  } break;

  case PH_E6: {
    const float lam = lamv[2 * j], lam_init = lamv[2 * j + 1];
    for (int it = bid; it < 16384; it += nb) {
      int pair = it * 16 + (tid >> 4), t = pair >> 3, hd = pair & 7, d = (tid & 15) * 4;
      f32x4 o1 = *(const f32x4*)(OD + (size_t)t * 512 + hd * 64 + d);
      f32x4 o2 = *(const f32x4*)(OD + (size_t)T_ * 512 + (size_t)t * 512 + hd * 64 + d);
      f32x4 v = o1 - lam * o2;
      float ss = v[0] * v[0] + v[1] * v[1] + v[2] * v[2] + v[3] * v[3];
      ss = row16_sum(ss);
      float r = rsqrtf(ss / 64.f + 1e-6f) * (1.f - lam_init);
      const float* g = P.ev_subln + j * 64 + d;
      u32x2 pk = {pack_bf16(v[0] * r * g[0], v[1] * r * g[1]), pack_bf16(v[2] * r * g[2], v[3] * r * g[3])};
      *(u32x2*)(RO + (size_t)t * 1024 + 512 + hd * 64 + d) = pk;
    }
  } break;

  case PH_MIXO: {
    EpiResid epi{(bf16_t*)RB, L == 0 ? P.x : nullptr, hbB};
    const bf16_t* Wt = (L & 1) ? (Wo + WO_O) : (We + WE_O);
    const int n1 = 128 * 8;
    for (int j = li; j < 128; j += nloc) gemm_tile<4>(RO, 1024, Wt, 1024, (xcd + 8 * (j >> 3)) * 256, (j & 7) * 128, lds, epi);
    for (int it = bid; it < 4096; it += nb) conv_item(P.p + (size_t)L * T_ * 256, (bf16_t*)OD, it);
  } break;

  case PH_LN1: {
    const bf16_t* y = (const bf16_t*)RB;
    const float* g = P.ln1_g + L * 1024; const float* bb = P.ln1_b + L * 1024;
    for (int it = bid; it < T_ / 4; it += nb) {
      int t = it * 4 + w;
      f32x4 v[4]; float s = 0.f;
#pragma unroll
      for (int k = 0; k < 4; ++k) {
        const u32x2 yy = *(const u32x2*)(y + (size_t)t * 1024 + 256 * k + 4 * lane);
        v[k] = f32x4{bf_lo(yy[0]), bf_hi(yy[0]), bf_lo(yy[1]), bf_hi(yy[1])};
        s += v[k][0] + v[k][1] + v[k][2] + v[k][3];
      }
      float mu = wave_sum(s) * (1.f / 1024.f);
      float q = 0.f;
#pragma unroll
      for (int k = 0; k < 4; ++k) { v[k] -= mu; q += v[k][0] * v[k][0] + v[k][1] * v[k][1] + v[k][2] * v[k][2] + v[k][3] * v[k][3]; }
      float rstd = rsqrtf(wave_sum(q) * (1.f / 1024.f) + 1e-5f);
      if (lane == 0) { f32x2 st = {mu, rstd}; *(f32x2*)(MS + 8 * MiB + (size_t)t * 8) = st; }
#pragma unroll
      for (int k = 0; k < 4; ++k) {
        int c = 256 * k + 4 * lane;
        f32x4 gg = *(const f32x4*)(g + c), b4 = *(const f32x4*)(bb + c);
        f32x4 o = v[k] * rstd * gg + b4;
        u32x2 pk = {pack_bf16(o[0], o[1]), pack_bf16(o[2], o[3])};
        *(u32x2*)(hbA + (size_t)t * 1024 + c) = pk;
      }
    }
  } break;

  case PH_P1: {
    EpiBf16 e1{RA, 2048, 2048};
    EpiBf16 e2{RO, 1024, 1024};
    const int n1 = 128 * 16, n2 = 128 * 8, n3 = 4096;
    int j = li;
    for (; j < 256; j += nloc) gemm_tile<4>(hbA, 1024, Wl + WL_Q, 1024, (xcd + 8 * (j >> 4)) * 256, (j & 15) * 128, lds, e1);
    for (; j < 256 + 128; j += nloc) { int j2 = j - 256; gemm_tile<4>((const bf16_t*)OD, 256, Wl + WL_PLE, 256, (xcd + 8 * (j2 >> 3)) * 256, (j2 & 7) * 128, lds, e2); }
    for (int it = bid; it < n3; it += nb) convfp8_item(P.peer_u + (size_t)L * 16384 * 1024, tabU, sclU, it);
    for (int it = bid; it < n3; it += nb) convfp8_item(P.peer_v + (size_t)L * 16384 * 1024, tabV, sclV, it);
  } break;

  case PH_P2: {
    float* st = (float*)lds;
    EpiLds epi{st};
    const int j16 = lane & 15, rr = lane >> 4;
    int ccode[4];
#pragma unroll
    for (int m = 0; m < 4; ++m) {
      int n = j16 + 16 * m, code = 255;
      if (n < 50) {
        int a = 0;
        for (; a < 16; ++a) { int cnt = 16 / (a + 1); if (n < cnt) break; n -= cnt; }
        code = a * 16 + n;
      }
      ccode[m] = code;
    }
    unsigned* T1 = (unsigned*)pe_idx;
    unsigned* T2 = (unsigned*)pe_g;
    for (int it = bid; it < 2048; it += nb) {
      const int mt = it >> 3, hd = it & 7;
#pragma unroll 1
      for (int half = 0; half < 2; ++half) {
        gemm_tile<2, true>(RA + hd * 256 + half * 128, 2048, Wl + (half ? WL_K2 : WL_K1), 128, mt * 128, 0, lds, epi);
        __syncthreads();
        unsigned* Th = half ? T2 : T1;
#pragma unroll 1
        for (int tk = 0; tk < 8; ++tk) {
          const int row = (w * 8 + tk) * 4 + rr;
          unsigned k[8];
#pragma unroll
          for (int m = 0; m < 8; ++m) {
            const int c = j16 + 16 * m;
            k[m] = (mono_key(st[row * 128 + ((c + row) & 127)]) & ~127u) | (unsigned)(127 - c);
          }
          sort8_desc(k);
          Th[(size_t)(mt * 128 + row) * 128 + hd * 16 + j16] = dpp_top16<8>(k, j16);
        }
        __syncthreads();
      }
#pragma unroll 1
      for (int tk = 0; tk < 8; ++tk) {
        const int row = (w * 8 + tk) * 4 + rr;
        const size_t obase = (size_t)(mt * 128 + row) * 128 + hd * 16;
        unsigned k[4];
#pragma unroll
        for (int m = 0; m < 4; ++m) {
          const int code = ccode[m];
          const float va = key_val(T1[obase + ((code >> 4) & 15)] & ~127u);
          const float vb = key_val(T2[obase + (code & 15)] & ~127u);
          k[m] = code < 255 ? ((mono_key(va + vb) & ~255u) | (unsigned)(255 - code)) : 0u;
        }
        sort4_desc(k);
        const unsigned kk = dpp_top16<4>(k, j16);
        const int code = 255 - (int)(kk & 255u);
        const float v = key_val(kk & ~255u);
        float mx = v;
        mx = fmaxf(mx, __builtin_bit_cast(float, __builtin_amdgcn_update_dpp(0, __builtin_bit_cast(int, mx), 0xB1, 0xf, 0xf, true)));
        mx = fmaxf(mx, __builtin_bit_cast(float, __builtin_amdgcn_update_dpp(0, __builtin_bit_cast(int, mx), 0x4E, 0xf, 0xf, true)));
        mx = fmaxf(mx, __builtin_bit_cast(float, __builtin_amdgcn_update_dpp(0, __builtin_bit_cast(int, mx), 0x141, 0xf, 0xf, true)));
        mx = fmaxf(mx, __builtin_bit_cast(float, __builtin_amdgcn_update_dpp(0, __builtin_bit_cast(int, mx), 0x140, 0xf, 0xf, true)));
        const float e = __expf(v - mx);
        const float sum = row16_sum(e);
        const int i1 = 127 - (int)(T1[obase + (code >> 4)] & 127u);
        const int i2 = 127 - (int)(T2[obase + (code & 15)] & 127u);
        pe_idx[obase + j16] = i1 * 128 + i2;
        pe_g[obase + j16] = e / sum;
      }
    }
  } break;

  case PH_P3:
  case PH_P3B: {
    const bool st1 = kind == PH_P3;
    float* cbuf = OD + 4 * 1024 * 1024;
    int* idx_s = (int*)lds + w * 640;
    float* g_s = (float*)(idx_s + 128);
    float* c_s = (float*)(idx_s + 256);
    float* su_s = (float*)(idx_s + 384);
    float* sv_s = (float*)(idx_s + 512);
    const float* g2 = P.ln2_g + L * 1024; const float* b2 = P.ln2_b + L * 1024;
    const int jl = lane & 15, grp = lane >> 4;
    for (int it = bid; it < T_ / 4; it += nb) {
      const int t = it * 4 + w;
      idx_s[lane] = pe_idx[(size_t)t * 128 + lane]; idx_s[64 + lane] = pe_idx[(size_t)t * 128 + 64 + lane];
      if (!st1) {
        c_s[lane] = cbuf[(size_t)t * 128 + lane]; c_s[64 + lane] = cbuf[(size_t)t * 128 + 64 + lane];
      }
      if (st1) {
      g_s[lane] = pe_g[(size_t)t * 128 + lane]; g_s[64 + lane] = pe_g[(size_t)t * 128 + 64 + lane];
      u32x4 xq[4][2];
#pragma unroll
      for (int i = 0; i < 4; ++i) {
        xq[i][0] = *(const u32x4*)(hbA + (size_t)t * 1024 + 256 * i + 16 * jl);
        xq[i][1] = *(const u32x4*)(hbA + (size_t)t * 1024 + 256 * i + 16 * jl + 8);
      }
      su_s[lane] = sclU[idx_s[lane]]; su_s[64 + lane] = sclU[idx_s[64 + lane]];
      sv_s[lane] = sclV[idx_s[lane]]; sv_s[64 + lane] = sclV[idx_s[64 + lane]];
      auto ld1 = [&](u32x4 (&u)[4], int k4) {
        const unsigned char* ur = tabU + (size_t)idx_s[4 * k4 + grp] * 1024 + 16 * jl;
#pragma unroll
        for (int i = 0; i < 4; ++i) u[i] = *(const u32x4*)(ur + 256 * i);
      };
      auto cp1 = [&](const u32x4 (&u)[4], int k4) {
        float acc = 0.f;
#pragma unroll
        for (int i = 0; i < 4; ++i) {
#pragma unroll
          for (int k = 0; k < 4; ++k) {
            bf16x2v lo = __builtin_amdgcn_cvt_scalef32_pk_bf16_fp8((int)u[i][k], 1.0f, false);
            bf16x2v hi = __builtin_amdgcn_cvt_scalef32_pk_bf16_fp8((int)u[i][k], 1.0f, true);
            unsigned x0 = xq[i][k >> 1][(2 * k) & 3], x1 = xq[i][k >> 1][(2 * k + 1) & 3];
            acc = __builtin_amdgcn_fdot2_f32_bf16(lo, __builtin_bit_cast(bf16x2v, x0), acc, false);
            acc = __builtin_amdgcn_fdot2_f32_bf16(hi, __builtin_bit_cast(bf16x2v, x1), acc, false);
          }
        }
        acc = row16_sum(acc) * su_s[4 * k4 + grp];
        float x3 = acc * acc * acc;
        float z = 0.7978845608028654f * (acc + 0.044715f * x3);
        float ez = __expf(2.f * z);
        float th = 1.f - 2.f / (ez + 1.f);
        float ge = 0.5f * acc * (1.f + th);
        if (jl == 0) c_s[4 * k4 + grp] = g_s[4 * k4 + grp] * ge * sv_s[4 * k4 + grp];
      };
      {
        u32x4 u0[4], u1[4], u2[4];
        ld1(u0, 0); ld1(u1, 1);
#pragma unroll 1
        for (int k4 = 0; k4 < 30; k4 += 3) {
          ld1(u2, k4 + 2); cp1(u0, k4);
          ld1(u0, k4 + 3); cp1(u1, k4 + 1);
          ld1(u1, k4 + 4); cp1(u2, k4 + 2);
        }
        cp1(u0, 30); cp1(u1, 31);
      }
      cbuf[(size_t)t * 128 + lane] = c_s[lane]; cbuf[(size_t)t * 128 + 64 + lane] = c_s[64 + lane];
      continue;
      }
      float out[16];
#pragma unroll
      for (int i = 0; i < 16; ++i) out[i] = 0.f;
      auto ld2 = [&](u32x4 (&v)[8], int kb) {
#pragma unroll
        for (int k = 0; k < 8; ++k) v[k] = *(const u32x4*)(tabV + (size_t)idx_s[8 * kb + k] * 1024 + 16 * lane);
      };
      auto cp2 = [&](const u32x4 (&v)[8], int kb) {
#pragma unroll
        for (int k = 0; k < 8; ++k) {
          const float c = c_s[8 * kb + k];
#pragma unroll
          for (int e = 0; e < 4; ++e) {
            f32x2 lo = __builtin_amdgcn_cvt_pk_f32_fp8((int)v[k][e], false);
            f32x2 hi = __builtin_amdgcn_cvt_pk_f32_fp8((int)v[k][e], true);
            out[4 * e] = fmaf(c, lo[0], out[4 * e]); out[4 * e + 1] = fmaf(c, lo[1], out[4 * e + 1]);
            out[4 * e + 2] = fmaf(c, hi[0], out[4 * e + 2]); out[4 * e + 3] = fmaf(c, hi[1], out[4 * e + 3]);
          }
        }
      };
      {
        u32x4 v0[8], v1[8];
        ld2(v0, 0);
#pragma unroll 1
        for (int kb = 0; kb < 16; kb += 2) {
          ld2(v1, kb + 1); cp2(v0, kb);
          if (kb + 2 < 16) ld2(v0, kb + 2);
          cp2(v1, kb + 1);
        }
      }
      float* hr = Hf + (size_t)t * 1024 + 16 * lane;
      float* hw = hr;
      const f32x2 st1v = *(const f32x2*)(MS + 8 * MiB + (size_t)t * 8);
      bf16_t* hbw = (dry ? RA : hbA) + (size_t)t * 1024 + 16 * lane;
      float s = 0.f;
#pragma unroll
      for (int k = 0; k < 4; ++k) {
        const u32x2 yy = *(const u32x2*)((const bf16_t*)RB + (size_t)t * 1024 + 16 * lane + 4 * k);
        const f32x4 yv = {bf_lo(yy[0]), bf_hi(yy[0]), bf_lo(yy[1]), bf_hi(yy[1])};
        const f32x4 g1 = *(const f32x4*)(P.ln1_g + L * 1024 + 16 * lane + 4 * k);
        const f32x4 b1 = *(const f32x4*)(P.ln1_b + L * 1024 + 16 * lane + 4 * k);
        const f32x4 a = (yv - st1v[0]) * st1v[1] * g1 + b1;
#pragma unroll
        for (int e = 0; e < 4; ++e) { out[4 * k + e] += DN_ALPHA * a[e]; s += out[4 * k + e]; }
      }
      float mu = wave_sum(s) * (1.f / 1024.f);
      float q = 0.f;
#pragma unroll
      for (int i = 0; i < 16; ++i) { out[i] -= mu; q += out[i] * out[i]; }
      float rstd = rsqrtf(wave_sum(q) * (1.f / 1024.f) + 1e-5f);
      unsigned pk[8];
#pragma unroll
      for (int k = 0; k < 4; ++k) {
        f32x4 ga = *(const f32x4*)(g2 + 16 * lane + 4 * k), ba = *(const f32x4*)(b2 + 16 * lane + 4 * k);
        f32x4 oa;
#pragma unroll
        for (int e = 0; e < 4; ++e) oa[e] = out[4 * k + e] * rstd * ga[e] + ba[e];
        pk[2 * k] = pack_bf16(oa[0], oa[1]); pk[2 * k + 1] = pack_bf16(oa[2], oa[3]);
      }
      u32x4 p0 = {pk[0], pk[1], pk[2], pk[3]}, p1 = {pk[4], pk[5], pk[6], pk[7]};
      *(u32x4*)hbw = p0; *(u32x4*)(hbw + 8) = p1;
    }
  } break;

  case PH_G2: {
    EpiGate epi{hbA, dry ? (float*)RB : (L == 3 ? P.out : nullptr), dry ? RA : hbB, RO, P.ple_gate_b + L * 1024};
    for (int j = li; j < 128; j += nloc) gemm_tile<4>(hbA, 1024, Wl + WL_G, 1024, (xcd + 8 * (j >> 3)) * 256, (j & 7) * 128, lds, epi);
  } break;

  case PH_O1: {
    EpiBf16 epi{RA, NO, 2640};
    const int ntn = NO / 128;
    for (int j = li; j < 16 * ntn; j += nloc) gemm_tile<4>(hbB, 1024, Wo + WO_IN, 1024, (xcd + 8 * (j / ntn)) * 256, (j % ntn) * 128, lds, epi);
  } break;

  case PH_O2: {
    {
      unsigned char* kv8 = (unsigned char*)(RB + 128 * MiB);
      for (int it = bid; it < 8192; it += nb) {
        const int idx = it * 256 + tid, t = idx >> 6, e8 = idx & 63;
        const u32x4 v = *(const u32x4*)(RA + (size_t)t * NO + 1024 + 8 * e8);
        int p0 = 0, p1 = 0;
        p0 = __builtin_amdgcn_cvt_pk_fp8_f32(bf_lo(v[0]), bf_hi(v[0]), p0, false);
        p0 = __builtin_amdgcn_cvt_pk_fp8_f32(bf_lo(v[1]), bf_hi(v[1]), p0, true);
        p1 = __builtin_amdgcn_cvt_pk_fp8_f32(bf_lo(v[2]), bf_hi(v[2]), p1, false);
        p1 = __builtin_amdgcn_cvt_pk_fp8_f32(bf_lo(v[3]), bf_hi(v[3]), p1, true);
        u32x2 o = {(unsigned)p0, (unsigned)p1};
        *(u32x2*)(kv8 + (size_t)t * 512 + 8 * e8) = o;
      }
    }
    for (int it = bid; it < 34816; it += nb) {
      int idx = it * 256 + tid, t = idx / 272, r = idx % 272, hd = r >> 4, f = r & 15;
      bf16_t* q = RA + (size_t)t * NO + (hd < 16 ? 1536 + hd * 64 : 2560);
      float x1 = bf2f(q[f]), x2 = bf2f(q[16 + f]);
      float cs = cstab[(t * 16 + f) * 2], sn = cstab[(t * 16 + f) * 2 + 1];
      q[f] = f2bf(x1 * cs - x2 * sn);
      q[16 + f] = f2bf(x2 * cs + x1 * sn);
    }
  } break;

  case PH_O3: {
    float* scr = (float*)RB + (size_t)bid * 16 * 4096;
    char* qi_s = lds;
    float* w_s = (float*)(lds + 33024);
    int* sel = (int*)lds + w * 256;
    bf16_t* q_s = (bf16_t*)(lds + 4096) + w * 1024;
    float* p_s = (float*)(lds + 12288) + w * 1024;
    int* rel_s = (int*)(lds + 28672) + w * 256;
    const unsigned char* kv8 = (const unsigned char*)(RB + 128 * MiB);
    for (int it = bid; it < 2048; it += nb) {
      const int qtile = 255 - (it >> 3), b = it & 7;
      const int q0 = qtile * 16, tok0 = b * S_;
      const int nk = 64 * ((q0 >> 6) + 1);
      __syncthreads();
#pragma unroll
      for (int i = 0; i < 8; ++i) {
        int p = tid + 256 * i, q = p >> 7, c = p & 127;
        *(u32x4*)(qi_s + q * 2064 + c * 16) = *(const u32x4*)(RA + (size_t)(tok0 + q0 + q) * NO + 1536 + 8 * c);
      }
      { int q = tid >> 4, hd = tid & 15; w_s[hd * 16 + q] = bf2f(RA[(size_t)(tok0 + q0 + q) * NO + 2624 + hd]) * (0.25f * 0.125f); }
      __syncthreads();
      const int l15 = lane & 15, kq = lane >> 4;
      if (nk > 256)
      for (int kc = w; kc < (nk >> 6); kc += 4) {
        const int k0 = kc * 64;
        bf16x8 kf[4][2];
#pragma unroll
        for (int tl = 0; tl < 4; ++tl)
#pragma unroll
          for (int s = 0; s < 2; ++s)
            kf[tl][s] = *(const bf16x8*)(RA + (size_t)(tok0 + k0 + 16 * tl + l15) * NO + 2560 + 32 * s + 8 * kq);
        f32x4 sc[4];
#pragma unroll
        for (int tl = 0; tl < 4; ++tl) sc[tl] = f32x4{0.f, 0.f, 0.f, 0.f};
#pragma unroll 1
        for (int hd = 0; hd < 16; ++hd) {
          bf16x8 a0 = *(const bf16x8*)(qi_s + l15 * 2064 + hd * 128 + kq * 16);
          bf16x8 a1 = *(const bf16x8*)(qi_s + l15 * 2064 + hd * 128 + 64 + kq * 16);
          f32x4 wv = *(const f32x4*)(w_s + hd * 16 + 4 * kq);
#pragma unroll
          for (int tl = 0; tl < 4; ++tl) {
            f32x4 d = f32x4{0.f, 0.f, 0.f, 0.f};
            d = mfma16(a0, kf[tl][0], d);
            d = mfma16(a1, kf[tl][1], d);
#pragma unroll
            for (int jj = 0; jj < 4; ++jj) sc[tl][jj] = fmaf(wv[jj], fmaxf(d[jj], 0.f), sc[tl][jj]);
          }
        }
#pragma unroll
        for (int tl = 0; tl < 4; ++tl)
#pragma unroll
          for (int jj = 0; jj < 4; ++jj) __builtin_nontemporal_store(sc[tl][jj], scr + (4 * kq + jj) * 4096 + k0 + 16 * tl + l15);
      }
      __syncthreads();
      for (int qq = 0; qq < 4; ++qq) {
        const int q = 4 * w + qq, tok = tok0 + q0 + q;
        int nvalid;
        if (nk <= 256) {
#pragma unroll
          for (int r = 0; r < 4; ++r) { int slot = lane + 64 * r; if (slot < nk) sel[slot] = slot; }
          nvalid = nk;
        } else {
          const int nreg = nk >> 6;
          unsigned key[64];
#pragma unroll
          for (int r4 = 0; r4 < 16; ++r4) {
            const u32x4 v = __builtin_nontemporal_load((const u32x4*)(scr + q * 4096 + 256 * r4 + 4 * lane));
            key[4 * r4] = v[0]; key[4 * r4 + 1] = v[1]; key[4 * r4 + 2] = v[2]; key[4 * r4 + 3] = v[3];
          }
#pragma unroll
          for (int r = 0; r < 64; ++r) {
            const unsigned u = key[r];
            const unsigned kk = (u & 0x80000000u) ? ~u : (u | 0x80000000u);
            key[r] = (256 * (r >> 2) + 4 * lane < nk) ? kk : 0u;
          }
          unsigned prefix = 0;
          for (int bit = 31; bit >= 0; --bit) {
            const unsigned cand = prefix | (1u << bit);
            int cl = 0;
#pragma unroll
            for (int g8 = 0; g8 < 8; ++g8) {
              if (8 * g8 < nreg) {
#pragma unroll
                for (int r = 8 * g8; r < 8 * g8 + 8; ++r) cl += (key[r] >= cand) ? 1 : 0;
              }
            }
            cl += __builtin_amdgcn_update_dpp(0, cl, 0xB1, 0xf, 0xf, true);
            cl += __builtin_amdgcn_update_dpp(0, cl, 0x4E, 0xf, 0xf, true);
            cl += __builtin_amdgcn_update_dpp(0, cl, 0x141, 0xf, 0xf, true);
            cl += __builtin_amdgcn_update_dpp(0, cl, 0x140, 0xf, 0xf, true);
            const int cnt = __builtin_amdgcn_readlane(cl, 0) + __builtin_amdgcn_readlane(cl, 16) +
                            __builtin_amdgcn_readlane(cl, 32) + __builtin_amdgcn_readlane(cl, 48);
            if (cnt == 256) { prefix = cand - 1u; break; }
            if (cnt > 256) prefix = cand;
          }
          int cgt = 0;
#pragma unroll
          for (int g8 = 0; g8 < 8; ++g8) {
            if (8 * g8 < nreg) {
#pragma unroll
              for (int r = 8 * g8; r < 8 * g8 + 8; ++r) cgt += __popcll(__ballot(key[r] > prefix));
            }
          }
          const int need = 256 - cgt;
          int base = 0, eqc = 0;
          const unsigned long long ltmask = (1ull << lane) - 1ull;
#pragma unroll
          for (int g8 = 0; g8 < 8; ++g8) {
            if (8 * g8 < nreg) {
#pragma unroll
              for (int r = 8 * g8; r < 8 * g8 + 8; ++r) {
                bool gt = key[r] > prefix, eq = key[r] == prefix;
                unsigned long long meq = __ballot(eq);
                int eqb = eqc + __popcll(meq & ltmask);
                bool take = gt || (eq && eqb < need);
                unsigned long long mt = __ballot(take);
                if (take) sel[base + __popcll(mt & ltmask)] = 256 * (r >> 2) + 4 * lane + (r & 3);
                base += __popcll(mt);
                eqc += __popcll(meq);
              }
            }
          }
          nvalid = 256;
        }
        const int posq = P.pos[tok];
        {
          const bf16_t* qg = RA + (size_t)tok * NO + 16 * lane;
          *(u32x4*)(q_s + 16 * lane) = *(const u32x4*)qg;
          *(u32x4*)(q_s + 16 * lane + 8) = *(const u32x4*)(qg + 8);
        }
        auto ldk = [&](u32x4 (&kr)[4], int g, int jj) {
          const int slot = lane + 64 * jj;
          const int key = slot < nvalid ? sel[slot] : 0;
          const unsigned char* krow = kv8 + (size_t)(tok0 + key) * 512 + g * 64;
#pragma unroll
          for (int c = 0; c < 4; ++c) kr[c] = *(const u32x4*)(krow + 16 * c);
        };
#pragma unroll
        for (int jj = 0; jj < 4; ++jj) {
          const int slot = lane + 64 * jj;
          const int key = slot < nvalid ? sel[slot] : 0;
          int rel = P.pos[tok0 + key] - posq;
          rel_s[slot] = (min(max(rel, -256), 256) + 256) * 16;
        }
        u32x4 kcur[4];
        ldk(kcur, 0, 0);
#pragma unroll 1
        for (int g = 0; g < 4; ++g) {
#pragma unroll 1
          for (int jj = 0; jj < 4; ++jj) {
            const int slot = lane + 64 * jj;
            const bool valid = slot < nvalid;
            const f32x4 bias = *(const f32x4*)(lutC + rel_s[slot] + g * 4);
            u32x4 knxt[4];
            {
              int gn = g, jn = jj + 1;
              if (jn == 4) { jn = 0; gn = g + 1; }
              if (gn < 4) ldk(knxt, gn, jn);
            }
            unsigned kb[32];
#pragma unroll
            for (int d = 0; d < 16; ++d) {
              kb[2 * d] = __builtin_bit_cast(unsigned, __builtin_amdgcn_cvt_scalef32_pk_bf16_fp8((int)kcur[d >> 2][d & 3], 1.0f, false));
              kb[2 * d + 1] = __builtin_bit_cast(unsigned, __builtin_amdgcn_cvt_scalef32_pk_bf16_fp8((int)kcur[d >> 2][d & 3], 1.0f, true));
            }
            f32x4 tv;
#pragma unroll
            for (int hh = 0; hh < 4; ++hh) {
              float a0 = 0.f, a1 = 0.f;
#pragma unroll
              for (int c4 = 0; c4 < 8; c4 += 4) {
                u32x4 qv[4];
#pragma unroll
                for (int c = 0; c < 4; ++c) qv[c] = *(const u32x4*)(q_s + (g * 4 + hh) * 64 + 8 * (c4 + c));
#pragma unroll
                for (int c = 0; c < 4; c += 2) {
                  a0 = dot2(kb[4 * (c4 + c) + 0], qv[c][0], a0); a1 = dot2(kb[4 * (c4 + c + 1) + 0], qv[c + 1][0], a1);
                  a0 = dot2(kb[4 * (c4 + c) + 1], qv[c][1], a0); a1 = dot2(kb[4 * (c4 + c + 1) + 1], qv[c + 1][1], a1);
                  a0 = dot2(kb[4 * (c4 + c) + 2], qv[c][2], a0); a1 = dot2(kb[4 * (c4 + c + 1) + 2], qv[c + 1][2], a1);
                  a0 = dot2(kb[4 * (c4 + c) + 3], qv[c][3], a0); a1 = dot2(kb[4 * (c4 + c + 1) + 3], qv[c + 1][3], a1);
                }
              }
              tv[hh] = valid ? fmaf(a0 + a1, 0.125f * L2E, bias[hh]) : -INFINITY;
            }
            *(f32x4*)(p_s + slot * 4) = tv;
#pragma unroll
            for (int c = 0; c < 4; ++c) kcur[c] = knxt[c];
          }
          f32x4 sc4[4];
#pragma unroll
          for (int jj = 0; jj < 4; ++jj) sc4[jj] = *(const f32x4*)(p_s + (lane + 64 * jj) * 4);
          float inv[4];
#pragma unroll
          for (int hh = 0; hh < 4; ++hh) {
            float mx = fmaxf(fmaxf(sc4[0][hh], sc4[1][hh]), fmaxf(sc4[2][hh], sc4[3][hh]));
            mx = wave_max(mx);
            float sm = 0.f;
#pragma unroll
            for (int jj = 0; jj < 4; ++jj) { sc4[jj][hh] = __builtin_amdgcn_exp2f(sc4[jj][hh] - mx); sm += sc4[jj][hh]; }
            sm = wave_sum(sm);
            inv[hh] = 1.f / sm;
          }
#pragma unroll
          for (int jj = 0; jj < 4; ++jj) {
            f32x4 pv = {sc4[jj][0] * inv[0], sc4[jj][1] * inv[1], sc4[jj][2] * inv[2], sc4[jj][3] * inv[3]};
            *(f32x4*)(p_s + (lane + 64 * jj) * 4) = pv;
          }
          const int ks = lane >> 3, dc = lane & 7;
          f32x2 oa[4][4];
#pragma unroll
          for (int hh = 0; hh < 4; ++hh)
#pragma unroll
            for (int d = 0; d < 4; ++d) oa[hh][d] = f32x2{0.f, 0.f};
          const unsigned char* vbase = kv8 + (size_t)tok0 * 512 + 256 + g * 64 + 8 * dc;
          auto ldv = [&](u32x2& v, int i) {
            const int slot = 8 * i + ks;
            v = *(const u32x2*)(vbase + (size_t)sel[slot < nvalid ? slot : 0] * 512);
          };
          auto cpv = [&](const u32x2& v, int i) {
            const f32x4 pv = *(const f32x4*)(p_s + (8 * i + ks) * 4);
            f32x2 vv[4];
            vv[0] = __builtin_amdgcn_cvt_pk_f32_fp8((int)v[0], false); vv[1] = __builtin_amdgcn_cvt_pk_f32_fp8((int)v[0], true);
            vv[2] = __builtin_amdgcn_cvt_pk_f32_fp8((int)v[1], false); vv[3] = __builtin_amdgcn_cvt_pk_f32_fp8((int)v[1], true);
#pragma unroll
            for (int e = 0; e < 4; ++e) {
#pragma unroll
              for (int hh = 0; hh < 4; ++hh) oa[hh][e] = __builtin_elementwise_fma(f32x2{pv[hh], pv[hh]}, vv[e], oa[hh][e]);
            }
          };
          const int nit = nvalid >> 3;
          u32x2 vr[8];
#pragma unroll
          for (int k = 0; k < 7; ++k) ldv(vr[k], k);
#pragma unroll 1
          for (int i = 0; i < nit; i += 8) {
#pragma unroll
            for (int k = 0; k < 8; ++k) {
              if (i + k + 7 < nit) ldv(vr[(k + 7) & 7], i + k + 7);
              cpv(vr[k], i + k);
            }
          }
#pragma unroll
          for (int hh = 0; hh < 4; ++hh)
#pragma unroll
            for (int d = 0; d < 4; ++d)
#pragma unroll
              for (int z = 0; z < 2; ++z) {
                float a = oa[hh][d][z];
                a += __shfl_xor(a, 8); a += __shfl_xor(a, 16); a += __shfl_xor(a, 32);
                oa[hh][d][z] = a;
              }
          if (ks == 0) {
#pragma unroll
            for (int hh = 0; hh < 4; ++hh) {
              u32x4 pk = {pack_bf16(oa[hh][0][0], oa[hh][0][1]), pack_bf16(oa[hh][1][0], oa[hh][1][1]), pack_bf16(oa[hh][2][0], oa[hh][2][1]), pack_bf16(oa[hh][3][0], oa[hh][3][1])};
              *(u32x4*)(RO + (size_t)tok * 1024 + (g * 4 + hh) * 64 + 8 * dc) = pk;
            }
          }
        }
      }
    }
  } break;
  default: break;
  }
}

#define XB_TMO      128
#define XB_XCNT(j)  (256  + 64 * (j))
#define XB_XSUB(j)  (1280 + 64 * (j))
#define XB_XGEN(j)  (2304 + 64 * (j))
#define XB_TOP      3328
#define XB_TOPGEN   3392
#define XCD_BAR_WORDS 3456
#define XB_SPIN_CAP (1u << 20)
#define LAS __attribute__((address_space(3)))
DI unsigned xb_ld(unsigned* p)              { return __hip_atomic_load(p, __ATOMIC_RELAXED, __HIP_MEMORY_SCOPE_AGENT); }
DI unsigned xb_add(unsigned* p, unsigned v) { return __hip_atomic_fetch_add(p, v, __ATOMIC_RELAXED, __HIP_MEMORY_SCOPE_AGENT); }
DI unsigned xb_xcc_id() { return (unsigned)__builtin_amdgcn_s_getreg((3 << 11) | 20) & 0xFu; }
#define XB_SPIN(cond, bar) do { unsigned _sp = 0; while (cond) { __builtin_amdgcn_s_sleep(1); \
    if ((++_sp & 255u) == 0u) { if (xb_ld(&(bar)[XB_TMO])) break; if (_sp > XB_SPIN_CAP) { atomicAdd(&(bar)[XB_TMO], 1u); break; } } } } while (0)
struct XcdBarrier { unsigned* bar; unsigned x; volatile LAS unsigned* st; };
DI XcdBarrier xcd_barrier_post(unsigned* bar, volatile LAS unsigned* st) {
  XcdBarrier b; b.bar = bar; b.x = xb_xcc_id(); b.st = st;
  if (threadIdx.x == 0) (void)xb_add(&bar[XB_XCNT(b.x)], 1u);
  return b;
}
DI void xcd_barrier_complete(unsigned* bar, unsigned x, unsigned& nloc, unsigned& nx) {
  const unsigned G = gridDim.x * gridDim.y * gridDim.z;
  unsigned sum, cnt, mine, sp = 0u;
  for (;;) {
    sum = 0u; cnt = 0u; mine = 0u;
#pragma unroll
    for (unsigned j = 0; j < 16; ++j) { const unsigned c = xb_ld(&bar[XB_XCNT(j)]); sum += c; cnt += (c > 0u) ? 1u : 0u; mine = (j == x) ? c : mine; }
    if (sum == G) break;
    __builtin_amdgcn_s_sleep(1);
    if ((++sp & 255u) == 0u) { if (xb_ld(&bar[XB_TMO])) break; if (sp > XB_SPIN_CAP) { atomicAdd(&bar[XB_TMO], 1u); break; } }
  }
  nloc = mine > 0u ? mine : 1u; nx = cnt > 0u ? cnt : 1u;
}
DI void xcd_barrier(const XcdBarrier& b) {
  asm volatile("s_waitcnt vmcnt(0)" ::: "memory");
  __syncthreads();
  if (threadIdx.x == 0) {
    unsigned* bar = b.bar;
    __builtin_amdgcn_s_waitcnt(0);
    unsigned nloc = b.st[0], nx = b.st[1];
    if (nloc == 0u) { xcd_barrier_complete(bar, b.x, nloc, nx); b.st[0] = nloc; b.st[1] = nx; }
    const unsigned old = xb_add(&bar[XB_XSUB(b.x)], 1u);
    const unsigned gen = old / nloc;
    if (old + 1u == (gen + 1u) * nloc) {
      __builtin_amdgcn_fence(__ATOMIC_RELEASE, "agent");
      asm volatile("s_waitcnt vmcnt(0)" ::: "memory");
      const unsigned og = xb_add(&bar[XB_TOP], 1u);
      const unsigned tg = og / nx;
      if (og + 1u == (tg + 1u) * nx) xb_add(&bar[XB_TOPGEN], 1u);
      else XB_SPIN(xb_ld(&bar[XB_TOPGEN]) == tg, bar);
      __builtin_amdgcn_fence(__ATOMIC_ACQUIRE, "agent");
      xb_add(&bar[XB_XGEN(b.x)], 1u);
      asm volatile("s_waitcnt vmcnt(0)" ::: "memory");
    } else {
      XB_SPIN(xb_ld(&bar[XB_XGEN(b.x)]) == gen, bar);
      __builtin_amdgcn_fence(__ATOMIC_ACQUIRE, "agent");
      asm volatile("s_waitcnt vmcnt(0)" ::: "memory");
    }
  }
  __syncthreads();
}

DI void decode_phase(int ph, int& kind, int& layer) {
  if (ph == 0) { kind = PH_PRO; layer = 0; return; }
  int p = ph - 1;
  if (p < 12) layer = 0; else if (p < 22) { layer = 1; p -= 12; } else if (p < 34) { layer = 2; p -= 22; } else { layer = 3; p -= 34; }
  const int nmix = (layer & 1) ? 3 : 5;
  if (p < nmix) {
    kind = (layer & 1) ? PH_O1 + p : (p < 3 ? PH_E1 + p : PH_E5 + (p - 3));
    return;
  }
  const int q = p - nmix;
  kind = q < 5 ? PH_MIXO + q : (q == 5 ? PH_P3B : PH_G2);
}

constexpr size_t MS_BAR = 7 * MiB;
__global__ void __launch_bounds__(256, 2) megakernel(Params P) {
  __shared__ __attribute__((aligned(16))) char lds[65536];
  __shared__ uint4 xb_words;
  if (threadIdx.x == 0) xb_words = make_uint4(0u, 0u, 0u, 0u);
  __syncthreads();
  XcdBarrier xb = xcd_barrier_post((unsigned*)(P.ws + OFF_MISC + MS_BAR), (volatile LAS unsigned*)&xb_words);
  for (int ph = P.ph0; ph < P.ph1; ++ph) {
    int kind, layer;
    decode_phase(ph, kind, layer);
#ifdef ONLY_PHASE
    kind = ONLY_PHASE;
#endif
#ifdef DUP_MASK
    if ((DUP_MASK >> kind) & 1) {
#ifndef DUP_NOP
      run_phase(P, kind, layer, lds, true);
#endif
      xcd_barrier(xb);
    }
#endif
    run_phase(P, kind, layer, lds, false);
    if (ph + 1 < P.ph1) {
      if (ph == P.ph0) cg::this_grid().sync();
      else xcd_barrier(xb);
    }
  }
}

extern "C" void kernel_launch(void* const* d_in, const int* in_sizes, int n_in, void* d_out, int out_size, void* d_ws,
                              size_t ws_size, hipStream_t stream) {
  static int grid_blocks = 0;
  const int nph = 45;
  if (!grid_blocks) {
    int dev = 0, cus = 0, per_cu = 0;
    hipGetDevice(&dev);
    hipDeviceGetAttribute(&cus, hipDeviceAttributeMultiprocessorCount, dev);
    hipOccupancyMaxActiveBlocksPerMultiprocessor(&per_cu, megakernel, 256, 0);
    if (per_cu > 2) per_cu = 2;
    if (per_cu < 1) per_cu = 1;
    grid_blocks = cus * per_cu;
    if (grid_blocks > 512) grid_blocks = 512;
    grid_blocks &= ~7;
  }
  Params P{};
  const float** fp = (const float**)&P;
  (void)fp;
  P.x = (const float*)d_in[0]; P.p = (const float*)d_in[1]; P.pos = (const int*)d_in[2]; P.rel_bias = (const float*)d_in[3];
  P.ev_w_in = (const float*)d_in[4]; P.ev_w_uq = (const float*)d_in[5]; P.ev_w_ukv = (const float*)d_in[6];
  P.ev_q_norm = (const float*)d_in[7]; P.ev_kv_norm = (const float*)d_in[8]; P.lq1 = (const float*)d_in[9];
  P.lk1 = (const float*)d_in[10]; P.lq2 = (const float*)d_in[11]; P.lk2 = (const float*)d_in[12];
  P.ev_subln = (const float*)d_in[13]; P.ev_w_o = (const float*)d_in[14]; P.od_w_in = (const float*)d_in[15];
  P.od_w_o = (const float*)d_in[16]; P.ln1_g = (const float*)d_in[17]; P.ln1_b = (const float*)d_in[18];
  P.ln2_g = (const float*)d_in[19]; P.ln2_b = (const float*)d_in[20]; P.peer_w_q = (const float*)d_in[21];
  P.peer_k1 = (const float*)d_in[22]; P.peer_k2 = (const float*)d_in[23]; P.peer_u = (const float*)d_in[24];
  P.peer_v = (const float*)d_in[25]; P.ple_w = (const float*)d_in[26]; P.ple_gate_w = (const float*)d_in[27];
  P.ple_gate_b = (const float*)d_in[28];
  P.out = (float*)d_out; P.ws = (char*)d_ws;
#if MULTI_LAUNCH
  for (int ph = 0; ph < nph; ++ph) {
    P.ph0 = ph; P.ph1 = ph + 1;
    hipLaunchKernelGGL(megakernel, dim3(grid_blocks), dim3(256), 0, stream, P);
  }
#else
  P.ph0 = 0; P.ph1 = nph;
  hipMemsetAsync((char*)d_ws + OFF_MISC + MS_BAR, 0, XCD_BAR_WORDS * 4, stream);
  void* args[] = {&P};
  hipError_t e = hipLaunchCooperativeKernel((void*)megakernel, dim3(grid_blocks), dim3(256), args, 0, stream);
  if (e != hipSuccess) fprintf(stderr, "cooperative launch failed: %s (grid %d)\n", hipGetErrorString(e), grid_blocks);
#endif
}
```

```cpp
#include <hip/hip_runtime.h>
#include <hip/hip_cooperative_groups.h>
#include <stdint.h>
#include <cstdio>
namespace cg = cooperative_groups;

#ifndef MULTI_LAUNCH
#define MULTI_LAUNCH 0
#endif

typedef unsigned short bf16_t;
typedef __attribute__((ext_vector_type(8))) short bf16x8;
typedef __attribute__((ext_vector_type(16))) float f32x16;
typedef __attribute__((ext_vector_type(4))) float f32x4;
typedef __attribute__((ext_vector_type(2))) float f32x2;
typedef __attribute__((ext_vector_type(4))) unsigned u32x4;
typedef __attribute__((ext_vector_type(2))) unsigned u32x2;
typedef __attribute__((ext_vector_type(2))) __bf16 bf16x2v;

#define DI __device__ __forceinline__

constexpr int T_ = 32768, S_ = 4096;
constexpr float DN_ALPHA = 1.6817928305074290f;
constexpr float L2E = 1.4426950408889634f;
constexpr int NE = 2432;
constexpr int NO = 2688;

constexpr size_t MiB = 1024ull * 1024ull;
constexpr size_t OFF_TABU = 0, OFF_TABV = 32 * MiB, OFF_W = 64 * MiB, OFF_H = 128 * MiB, OFF_HBA = 256 * MiB,
                 OFF_HBB = 320 * MiB, OFF_RA = 384 * MiB, OFF_RB = 576 * MiB, OFF_RO = 736 * MiB, OFF_OD = 800 * MiB,
                 OFF_PK = 928 * MiB, OFF_MISC = 960 * MiB;
constexpr size_t RB_QA = 0, RB_KN = 48 * MiB, RB_VTA = 80 * MiB, RB_VTD = 112 * MiB;
constexpr size_t MS_CS = 0  , MS_LUTB = 4 * MiB  , MS_LUTC = 4 * MiB + 32768  ,
                 MS_PMM = 4 * MiB + 98304  , MS_LAM = 4 * MiB + 110592, MS_RSQ = 5 * MiB, MS_RSKV = 5 * MiB + 131072 * 2;
constexpr size_t WE_IN = 0, WE_UQ = 2490368, WE_UKV = WE_UQ + 393216, WE_O = WE_UKV + 262144, WE_SZ = 4194304;
constexpr size_t WO_BASE = 2 * WE_SZ, WO_IN = 0, WO_O = 2752512, WO_SZ = 3801088;
constexpr size_t WL_BASE = WO_BASE + 2 * WO_SZ, WL_Q = 0, WL_K1 = 2097152, WL_K2 = WL_K1 + 16384, WL_G = WL_K2 + 16384,
                 WL_PLE = WL_G + 1048576, WL_SZ = 3440640;

struct Params {
  const float *x, *p; const int* pos; const float* rel_bias;
  const float *ev_w_in, *ev_w_uq, *ev_w_ukv, *ev_q_norm, *ev_kv_norm, *lq1, *lk1, *lq2, *lk2, *ev_subln, *ev_w_o;
  const float *od_w_in, *od_w_o, *ln1_g, *ln1_b, *ln2_g, *ln2_b, *peer_w_q, *peer_k1, *peer_k2, *peer_u, *peer_v,
      *ple_w, *ple_gate_w, *ple_gate_b;
  float* out; char* ws; int ph0, ph1;
};

DI unsigned pack_bf16(float a, float b) {
  f32x2 v = {a, b};
  bf16x2v r = __builtin_convertvector(v, bf16x2v);
  return __builtin_bit_cast(unsigned, r);
}
DI bf16_t f2bf(float a) { return (bf16_t)(pack_bf16(a, 0.f) & 0xffffu); }
DI float bf_lo(unsigned u) { return __uint_as_float(u << 16); }
DI float bf_hi(unsigned u) { return __uint_as_float(u & 0xffff0000u); }
DI float bf2f(bf16_t x) { return __uint_as_float(((unsigned)x) << 16); }
DI float dot2(unsigned a, unsigned b, float c) {
  return __builtin_amdgcn_fdot2_f32_bf16(__builtin_bit_cast(bf16x2v, a), __builtin_bit_cast(bf16x2v, b), c, false);
}
DI float wave_sum(float v) {
#pragma unroll
  for (int o = 32; o >= 1; o >>= 1) v += __shfl_xor(v, o);
  return v;
}
DI float wave_max(float v) {
#pragma unroll
  for (int o = 32; o >= 1; o >>= 1) v = fmaxf(v, __shfl_xor(v, o));
  return v;
}
DI float row16_sum(float x) {
  x += __builtin_bit_cast(float, __builtin_amdgcn_update_dpp(0, __builtin_bit_cast(int, x), 0xB1, 0xf, 0xf, true));
  x += __builtin_bit_cast(float, __builtin_amdgcn_update_dpp(0, __builtin_bit_cast(int, x), 0x4E, 0xf, 0xf, true));
  x += __builtin_bit_cast(float, __builtin_amdgcn_update_dpp(0, __builtin_bit_cast(int, x), 0x141, 0xf, 0xf, true));
  x += __builtin_bit_cast(float, __builtin_amdgcn_update_dpp(0, __builtin_bit_cast(int, x), 0x140, 0xf, 0xf, true));
  return x;
}
DI f32x16 mfma32(bf16x8 a, bf16x8 b, f32x16 c) { return __builtin_amdgcn_mfma_f32_32x32x16_bf16(a, b, c, 0, 0, 0); }
DI f32x4 mfma16(bf16x8 a, bf16x8 b, f32x4 c) { return __builtin_amdgcn_mfma_f32_16x16x32_bf16(a, b, c, 0, 0, 0); }
DI int crow(int i, int h) { return (i & 3) + 8 * (i >> 2) + 4 * h; }

template <int WM, bool SYNC_EPI = false, int EXP = 0, class Epi>
DI void gemm_tile(const bf16_t* __restrict__ A, int lda, const bf16_t* __restrict__ Bt, int K, int m0, int n0,
                  char* lds, Epi& epi) {
  int tid_ = threadIdx.x; asm volatile("" : "+v"(tid_));
  const int tid = tid_, lane = tid & 63, w = tid >> 6, wm = w >> 1, wn = w & 1, hh = lane >> 5, l31 = lane & 31;
  constexpr int BM = 64 * WM;
  constexpr int NA = BM / 32;
  bf16_t* As = (bf16_t*)lds;
  bf16_t* Bs = As + BM * 72;
  f32x16 acc[WM][2];
#pragma unroll
  for (int a = 0; a < WM; ++a)
#pragma unroll
    for (int b = 0; b < 2; ++b)
#pragma unroll
      for (int i = 0; i < 16; ++i) acc[a][b][i] = 0.f;
  const int nk = K >> 6;
  u32x4 ra[NA], rb[4];
  const int prow = tid >> 3, pc = (tid & 7) * 8;
  const bf16_t* ag = A + (size_t)(m0 + prow) * lda + pc;
  const bf16_t* bg = Bt + (size_t)(n0 + prow) * K + pc;
  auto gload = [&](int kt) {
#pragma unroll
    for (int i = 0; i < NA; ++i) ra[i] = *(const u32x4*)(ag + (size_t)(32 * i) * lda + kt * 64);
#pragma unroll
    for (int i = 0; i < 4; ++i) rb[i] = *(const u32x4*)(bg + (size_t)(32 * i) * K + kt * 64);
  };
  auto lstore = [&]() {
#pragma unroll
    for (int i = 0; i < NA; ++i) *(u32x4*)(As + (prow + 32 * i) * 72 + pc) = ra[i];
#pragma unroll
    for (int i = 0; i < 4; ++i) *(u32x4*)(Bs + (prow + 32 * i) * 72 + pc) = rb[i];
  };
  gload(0);
  for (int kt = 0; kt < nk; ++kt) {
    if (EXP != 5) __syncthreads();
    if (EXP != 3 || kt == 0) lstore();
    if (EXP != 5) __syncthreads();
    if (EXP != 2 && EXP != 3) { if (kt + 1 < nk) gload(kt + 1); }
#pragma unroll
    for (int s = 0; s < 4; ++s) {
      if (EXP == 4) break;
      bf16x8 af[WM], bfr[2];
#pragma unroll
      for (int mt = 0; mt < WM; ++mt)
        af[mt] = *(const bf16x8*)(As + (32 * WM * wm + 32 * mt + l31) * 72 + s * 16 + hh * 8);
#pragma unroll
      for (int nt = 0; nt < 2; ++nt)
        bfr[nt] = *(const bf16x8*)(Bs + (64 * wn + 32 * nt + l31) * 72 + s * 16 + hh * 8);
#pragma unroll
      for (int mt = 0; mt < WM; ++mt)
#pragma unroll
        for (int nt = 0; nt < 2; ++nt) acc[mt][nt] = mfma32(af[mt], bfr[nt], acc[mt][nt]);
    }
  }
  if (SYNC_EPI) __syncthreads();
  if (EXP == 1) { if (acc[0][0][0] != 12345.678f) return; }
#pragma unroll
  for (int mt = 0; mt < WM; ++mt)
#pragma unroll
    for (int nt = 0; nt < 2; ++nt) epi(m0 + 32 * WM * wm + 32 * mt, n0 + 64 * wn + 32 * nt, acc[mt][nt], lane);
}

DI void store_vT(bf16_t* vT, int head, int dim, int r, float v0, float v1, float v2, float v3) {
  int b = r >> 12, s = r & 4095;
  u32x2 pk = {pack_bf16(v0, v1), pack_bf16(v2, v3)};
  *(u32x2*)(vT + ((size_t)((b * 8 + head) * 64 + dim)) * S_ + s) = pk;
}

struct EpiEvenProj {
  bf16_t* proj; bf16_t* vTd;
  DI void operator()(int rb, int cb, const f32x16& a, int lane) const {
    int c = cb + (lane & 31), h = lane >> 5;
    if (cb < 1824) {
#pragma unroll
      for (int i = 0; i < 16; ++i) proj[(size_t)(rb + crow(i, h)) * NE + c] = f2bf(a[i]);
    } else if (cb < 2336) {
      int cc = c - 1824, head = cc >> 6, dim = cc & 63;
#pragma unroll
      for (int g = 0; g < 4; ++g) store_vT(vTd, head, dim, rb + 8 * g + 4 * h, a[4 * g], a[4 * g + 1], a[4 * g + 2], a[4 * g + 3]);
    }
  }
};
struct EpiRowScaleBf16 {
  bf16_t* out; int ldo; const float* rs;
  DI void operator()(int rb, int cb, const f32x16& a, int lane) const {
    int c = cb + (lane & 31), h = lane >> 5;
#pragma unroll
    for (int i = 0; i < 16; ++i) { int r = rb + crow(i, h); out[(size_t)r * ldo + c] = f2bf(a[i] * rs[r]); }
  }
};
struct EpiKV {
  bf16_t* kn; bf16_t* vTa; const float* rs;
  DI void operator()(int rb, int cb, const f32x16& a, int lane) const {
    int c = cb + (lane & 31), h = lane >> 5, head = c >> 7, d = c & 127;
    if (d < 64) {
#pragma unroll
      for (int i = 0; i < 16; ++i) { int r = rb + crow(i, h); kn[(size_t)r * 512 + head * 64 + d] = f2bf(a[i] * rs[r]); }
    } else {
#pragma unroll
      for (int g = 0; g < 4; ++g) {
        int r = rb + 8 * g + 4 * h;
        store_vT(vTa, head, d - 64, r, a[4 * g] * rs[r], a[4 * g + 1] * rs[r + 1], a[4 * g + 2] * rs[r + 2], a[4 * g + 3] * rs[r + 3]);
      }
    }
  }
};
struct EpiBf16 {
  bf16_t* out; int ldo; int nvalid;
  DI void operator()(int rb, int cb, const f32x16& a, int lane) const {
    int c = cb + (lane & 31), h = lane >> 5;
    if (cb < nvalid) {
#pragma unroll
      for (int i = 0; i < 16; ++i) out[(size_t)(rb + crow(i, h)) * ldo + c] = f2bf(a[i]);
    }
  }
};
struct EpiResid {
  bf16_t* y; const float* hres; const bf16_t* hresb;
  DI void operator()(int rb, int cb, const f32x16& a, int lane) const {
    int c = cb + (lane & 31), h = lane >> 5;
    if (hres) {
#pragma unroll
      for (int i = 0; i < 16; ++i) { size_t o = (size_t)(rb + crow(i, h)) * 1024 + c; y[o] = f2bf(DN_ALPHA * hres[o] + a[i]); }
    } else {
#pragma unroll
      for (int i = 0; i < 16; ++i) { size_t o = (size_t)(rb + crow(i, h)) * 1024 + c; y[o] = f2bf(DN_ALPHA * bf2f(hresb[o]) + a[i]); }
    }
  }
};
struct EpiGate {
  const bf16_t* hin; float* outp; bf16_t* hb; const bf16_t* pw; const float* bg;
  DI void operator()(int rb, int cb, const f32x16& a, int lane) const {
    int c = cb + (lane & 31), h = lane >> 5;
    float bb = bg[c];
#pragma unroll
    for (int i = 0; i < 16; ++i) {
      size_t o = (size_t)(rb + crow(i, h)) * 1024 + c;
      float g = 1.f / (1.f + __expf(-(a[i] + bb)));
      float hn = bf2f(hin[o]) + g * bf2f(pw[o]);
      if (outp) outp[o] = hn;
      hb[o] = f2bf(hn);
    }
  }
};
struct EpiLds {
  float* s;
  DI void operator()(int rb, int cb, const f32x16& a, int lane) const {
    int c = (cb & 127) + (lane & 31), h = lane >> 5;
#pragma unroll
    for (int i = 0; i < 16; ++i) { int r = (rb & 127) + crow(i, h); s[r * 128 + ((c + r) & 127)] = a[i]; }
  }
};

DI void conv_item(const float* __restrict__ src, bf16_t* __restrict__ dst, int item) {
  int tid_ = threadIdx.x; asm volatile("" : "+v"(tid_));
  size_t o = (size_t)item * 2048 + tid_ * 8;
  f32x4 v0 = *(const f32x4*)(src + o), v1 = *(const f32x4*)(src + o + 4);
  u32x4 r = {pack_bf16(v0[0], v0[1]), pack_bf16(v0[2], v0[3]), pack_bf16(v1[0], v1[1]), pack_bf16(v1[2], v1[3])};
  *(u32x4*)(dst + o) = r;
}
DI void convfp8_item(const float* __restrict__ src, unsigned char* __restrict__ dst, float* __restrict__ inv_scale, int item) {
  int tid_ = threadIdx.x; asm volatile("" : "+v"(tid_));
  const int lane = tid_ & 63, row = item * 4 + (tid_ >> 6);
  const float* r = src + (size_t)row * 1024 + 16 * lane;
  f32x4 v[4];
  float am = 0.f;
#pragma unroll
  for (int k = 0; k < 4; ++k) {
    v[k] = *(const f32x4*)(r + 4 * k);
    am = fmaxf(am, fmaxf(fmaxf(fabsf(v[k][0]), fabsf(v[k][1])), fmaxf(fabsf(v[k][2]), fabsf(v[k][3]))));
  }
  am = wave_max(am);
  const float sc = am > 0.f ? 224.f / am : 1.f;
  u32x4 o;
#pragma unroll
  for (int k = 0; k < 4; ++k) {
    int p = 0;
    p = __builtin_amdgcn_cvt_pk_fp8_f32(v[k][0] * sc, v[k][1] * sc, p, false);
    p = __builtin_amdgcn_cvt_pk_fp8_f32(v[k][2] * sc, v[k][3] * sc, p, true);
    o[k] = (unsigned)p;
  }
  *(u32x4*)(dst + (size_t)row * 1024 + 16 * lane) = o;
  if (lane == 0) inv_scale[row] = 1.f / sc;
}
DI void tconv_item(const float* __restrict__ src, int K, int N, int Npad, bf16_t* __restrict__ dst,
                   const float* __restrict__ g, int item, char* lds) {
  float* tile = (float*)lds;
  int tid_ = threadIdx.x; asm volatile("" : "+v"(tid_));
  const int tid = tid_;
  const int tn = Npad >> 6;
  const int k0 = (item / tn) * 64, n0 = (item % tn) * 64;
#pragma unroll
  for (int i = 0; i < 4; ++i) {
    int r = (tid >> 4) + 16 * i, c4 = (tid & 15) * 4;
    f32x4 v = {0.f, 0.f, 0.f, 0.f};
    if (n0 + c4 < N) v = *(const f32x4*)(src + (size_t)(k0 + r) * N + n0 + c4);
    float sc = g ? g[k0 + r] : 1.f;
#pragma unroll
    for (int e = 0; e < 4; ++e) tile[r * 65 + c4 + e] = v[e] * sc;
  }
  __syncthreads();
  {
    int nl = tid >> 2, kp = (tid & 3) * 16;
    unsigned pk[8];
#pragma unroll
    for (int e = 0; e < 8; ++e) pk[e] = pack_bf16(tile[(kp + 2 * e) * 65 + nl], tile[(kp + 2 * e + 1) * 65 + nl]);
    bf16_t* d = dst + (size_t)(n0 + nl) * K + k0 + kp;
    u32x4 a = {pk[0], pk[1], pk[2], pk[3]}, b = {pk[4], pk[5], pk[6], pk[7]};
    *(u32x4*)d = a;
    *(u32x4*)(d + 8) = b;
  }
  __syncthreads();
}

DI int t5_bucket(int rel) {
  int n = rel < 0 ? -rel : rel;
  float fn = (float)(n > 1 ? n : 1);
  int large = 8 + (int)(logf(fn / 8.f) / 3.4657359027997265f * 8.f);
  large = large < 15 ? large : 15;
  return (rel > 0 ? 16 : 0) + (n < 8 ? n : large);
}

template <int DQK, bool BIAS>
DI void attn_item(const bf16_t* __restrict__ Qp, int qs, const bf16_t* __restrict__ K1p, int k1s,
                  const bf16_t* __restrict__ K2p, int k2s, const bf16_t* __restrict__ vT, const int* __restrict__ posb,
                  const float* __restrict__ lut, const int* __restrict__ pmm, int tok0  , int qt, float scale_l2e,
                  char* lds, bf16_t* ob, float* of, int ostride, const float* __restrict__ cst = nullptr) {
  constexpr int KST = DQK + 8;
  constexpr int NPC = DQK / 8;
  constexpr int NP = DQK / 32;
  constexpr int NS = DQK / 16;
  int tid_ = threadIdx.x; asm volatile("" : "+v"(tid_));
  const int tid = tid_, lane = tid & 63, w = tid >> 6, hh = lane >> 5, l31 = lane & 31;
  bf16_t* Ks = (bf16_t*)lds;
  bf16_t* Vs = (bf16_t*)(lds + 13312);
  int* posk = (int*)(lds + 22016);
  float* lut_s = (float*)(lds + 22272);
  const int qrow = 128 * qt + 32 * w + l31;
  const int ntile = 2 * qt + 2;
  const int mylast = 2 * qt + (w >> 1);
  bf16x8 qf[NS];
#pragma unroll
  for (int s = 0; s < NS; ++s) qf[s] = *(const bf16x8*)(Qp + (size_t)(tok0 + qrow) * qs + 16 * s + 8 * hh);
  if (DQK == 96) {
    const float* cp = cst + ((size_t)(tok0 + qrow) * 16 + 8 * hh) * 2;
    f32x4 cv[4];
#pragma unroll
    for (int k = 0; k < 4; ++k) cv[k] = *(const f32x4*)(cp + 4 * k);
#pragma unroll
    for (int j = 0; j < 8; ++j) {
      const float cs = cv[j >> 1][(2 * j) & 3], sn = cv[j >> 1][(2 * j + 1) & 3];
      const float x1 = bf2f((bf16_t)qf[NS - 2][j]), x2 = bf2f((bf16_t)qf[NS - 1][j]);
      qf[NS - 2][j] = (short)f2bf(x1 * cs - x2 * sn);
      qf[NS - 1][j] = (short)f2bf(x2 * cs + x1 * sn);
    }
  }
  int posq = 0, qmin = 0;
  if (BIAS) {
    posq = posb[qrow];
    qmin = posq;
#pragma unroll
    for (int o = 16; o >= 1; o >>= 1) { int t = __shfl_xor(qmin, o); qmin = t < qmin ? t : qmin; }
    __syncthreads();
    for (int i = tid; i < 513; i += 256) lut_s[i] = lut[i];
  }
  f32x16 oacc[2];
#pragma unroll
  for (int i = 0; i < 16; ++i) { oacc[0][i] = 0.f; oacc[1][i] = 0.f; }
  float mrun = -INFINITY, lrun = 0.f;
  u32x4 kr[NP], vr[2]; int pr = 0;
  auto gload = [&](int kt) {
    const int key0 = kt * 64;
#pragma unroll
    for (int i = 0; i < NP; ++i) {
      int p = tid + 256 * i, row = p / NPC, c = p % NPC;
      const bf16_t* src = (DQK == 32 || c < 8) ? K1p + (size_t)(tok0 + key0 + row) * k1s + 8 * c
                                                : K2p + (size_t)(tok0 + key0 + row) * k2s + 8 * (c - 8);
      kr[i] = *(const u32x4*)src;
    }
#pragma unroll
    for (int i = 0; i < 2; ++i) {
      int p = tid + 256 * i, d = p >> 3, c = p & 7;
      vr[i] = *(const u32x4*)(vT + (size_t)d * S_ + key0 + 8 * c);
    }
    if (BIAS && tid < 64) pr = posb[key0 + tid];
  };
  auto lstore = [&]() {
#pragma unroll
    for (int i = 0; i < NP; ++i) {
      int p = tid + 256 * i, row = p / NPC, c = p % NPC;
      *(u32x4*)(Ks + row * KST + 8 * c) = kr[i];
    }
#pragma unroll
    for (int i = 0; i < 2; ++i) {
      int p = tid + 256 * i, d = p >> 3, c = p & 7;
      u32x2 lo = {vr[i][0], vr[i][1]}, hi = {vr[i][2], vr[i][3]};
      *(u32x2*)(Vs + d * 68 + 8 * c) = lo;
      *(u32x2*)(Vs + d * 68 + 8 * c + 4) = hi;
    }
    if (BIAS && tid < 64) posk[tid] = pr;
  };
  gload(0);
  for (int kt = 0; kt < ntile; ++kt) {
    __syncthreads();
    lstore();
    __syncthreads();
    if (kt + 1 < ntile) gload(kt + 1);
    if (kt <= mylast) {
      f32x16 s0, s1;
#pragma unroll
      for (int i = 0; i < 16; ++i) { s0[i] = 0.f; s1[i] = 0.f; }
#pragma unroll
      for (int s = 0; s < NS; ++s) {
        bf16x8 k0 = *(const bf16x8*)(Ks + l31 * KST + 16 * s + 8 * hh);
        bf16x8 k1 = *(const bf16x8*)(Ks + (32 + l31) * KST + 16 * s + 8 * hh);
        s0 = mfma32(k0, qf[s], s0);
        s1 = mfma32(k1, qf[s], s1);
      }
      bool folded = true;
      float cst = 0.f;
      if (BIAS) {
        const int kmax = pmm[kt * 2 + 1];
        if (qmin - kmax >= 256) {
          cst = lut_s[0];
        } else {
          folded = false;
#pragma unroll
          for (int i = 0; i < 16; ++i) {
            int kk = crow(i, hh);
            int r0 = posk[kk] - posq, r1 = posk[kk + 32] - posq;
            r0 = min(max(r0, -256), 256) + 256;
            r1 = min(max(r1, -256), 256) + 256;
            s0[i] = fmaf(s0[i], scale_l2e, lut_s[r0]);
            s1[i] = fmaf(s1[i], scale_l2e, lut_s[r1]);
          }
        }
      }
      float mx = s0[0];
#pragma unroll
      for (int i = 0; i < 16; ++i) { mx = fmaxf(mx, s0[i]); mx = fmaxf(mx, s1[i]); }
      mx = fmaxf(mx, __shfl_xor(mx, 32));
      if (folded) mx = fmaf(mx, scale_l2e, cst);
      const float mnew = fmaxf(mrun, mx);
      const float alpha = __builtin_amdgcn_exp2f(mrun - mnew);
      mrun = mnew;
      float ps = 0.f;
      const float fsc = folded ? scale_l2e : 1.f;
      const float fof = folded ? cst - mnew : -mnew;
#pragma unroll
      for (int i = 0; i < 16; ++i) {
        s0[i] = __builtin_amdgcn_exp2f(fmaf(s0[i], fsc, fof));
        s1[i] = __builtin_amdgcn_exp2f(fmaf(s1[i], fsc, fof));
        ps += s0[i] + s1[i];
      }
      lrun = lrun * alpha + ps;
#pragma unroll
      for (int i = 0; i < 16; ++i) { oacc[0][i] *= alpha; oacc[1][i] *= alpha; }
#pragma unroll
      for (int st = 0; st < 2; ++st) {
#pragma unroll
        for (int s = 0; s < 2; ++s) {
          u32x4 pp;
          if (st == 0) {
            pp[0] = pack_bf16(s0[8 * s + 0], s0[8 * s + 1]); pp[1] = pack_bf16(s0[8 * s + 2], s0[8 * s + 3]);
            pp[2] = pack_bf16(s0[8 * s + 4], s0[8 * s + 5]); pp[3] = pack_bf16(s0[8 * s + 6], s0[8 * s + 7]);
          } else {
            pp[0] = pack_bf16(s1[8 * s + 0], s1[8 * s + 1]); pp[1] = pack_bf16(s1[8 * s + 2], s1[8 * s + 3]);
            pp[2] = pack_bf16(s1[8 * s + 4], s1[8 * s + 5]); pp[3] = pack_bf16(s1[8 * s + 6], s1[8 * s + 7]);
          }
          bf16x8 pf = __builtin_bit_cast(bf16x8, pp);
#pragma unroll
          for (int mt = 0; mt < 2; ++mt) {
            const bf16_t* vp = Vs + (32 * mt + l31) * 68 + 32 * st + 16 * s + 4 * hh;
            u32x2 a = *(const u32x2*)vp, b = *(const u32x2*)(vp + 8);
            u32x4 vv = {a[0], a[1], b[0], b[1]};
            oacc[mt] = mfma32(__builtin_bit_cast(bf16x8, vv), pf, oacc[mt]);
          }
        }
      }
    }
  }
  const float ltot = lrun + __shfl_xor(lrun, 32);
  const float inv = 1.f / ltot;
  const size_t orow = (size_t)(tok0 + qrow) * ostride;
#pragma unroll
  for (int mt = 0; mt < 2; ++mt)
#pragma unroll
    for (int g = 0; g < 4; ++g) {
      int d = 32 * mt + 8 * g + 4 * hh;
      float v0 = oacc[mt][4 * g] * inv, v1 = oacc[mt][4 * g + 1] * inv, v2 = oacc[mt][4 * g + 2] * inv, v3 = oacc[mt][4 * g + 3] * inv;
      if (ob) {
        u32x2 pk = {pack_bf16(v0, v1), pack_bf16(v2, v3)};
        *(u32x2*)(ob + orow + d) = pk;
      } else {
        f32x4 o = {v0, v1, v2, v3};
        *(f32x4*)(of + orow + d) = o;
      }
    }
}

DI void top16_insert(float (&v)[16], int (&id)[16], float x, int xi) {
  if (x > v[15]) {
#pragma unroll
    for (int p = 0; p < 16; ++p) {
      bool gt = x > v[p];
      float tv = gt ? v[p] : x; int ti = gt ? id[p] : xi;
      v[p] = gt ? x : v[p]; id[p] = gt ? xi : id[p];
      x = tv; xi = ti;
    }
  }
}
DI void top16_merge(float (&v)[16], int (&id)[16]) {
  float nv[16]; int ni[16];
#pragma unroll
  for (int i = 0; i < 16; ++i) {
    float pv = __shfl_xor(v[15 - i], 1); int pi = __shfl_xor(id[15 - i], 1);
    bool take = (pv > v[i]) || (pv == v[i] && pi < id[i]);
    nv[i] = take ? pv : v[i]; ni[i] = take ? pi : id[i];
  }
#pragma unroll
  for (int i = 0; i < 16; ++i) { v[i] = nv[i]; id[i] = ni[i]; }
}

DI unsigned mono_key(float f) { unsigned u = __float_as_uint(f); return (u >> 31) ? ~u : (u | 0x80000000u); }
DI float key_val(unsigned k) { return __uint_as_float((k >> 31) ? (k & 0x7fffffffu) : ~k); }
DI void ce_desc(unsigned& a, unsigned& b) { unsigned hi = a > b ? a : b, lo = a > b ? b : a; a = hi; b = lo; }
DI void sort8_desc(unsigned (&k)[8]) {
  ce_desc(k[0], k[1]); ce_desc(k[2], k[3]); ce_desc(k[4], k[5]); ce_desc(k[6], k[7]);
  ce_desc(k[0], k[2]); ce_desc(k[1], k[3]); ce_desc(k[4], k[6]); ce_desc(k[5], k[7]);
  ce_desc(k[1], k[2]); ce_desc(k[5], k[6]);
  ce_desc(k[0], k[4]); ce_desc(k[1], k[5]); ce_desc(k[2], k[6]); ce_desc(k[3], k[7]);
  ce_desc(k[2], k[4]); ce_desc(k[3], k[5]);
  ce_desc(k[1], k[2]); ce_desc(k[3], k[4]); ce_desc(k[5], k[6]);
}
DI void sort4_desc(unsigned (&k)[4]) {
  ce_desc(k[0], k[1]); ce_desc(k[2], k[3]); ce_desc(k[0], k[2]); ce_desc(k[1], k[3]); ce_desc(k[1], k[2]);
}
DI unsigned umax_dpp(unsigned m, int) { return m; }
template <int N>
DI unsigned dpp_top16(unsigned (&k)[N], int j16) {
  unsigned res = 0;
#pragma unroll
  for (int r = 0; r < 16; ++r) {
    unsigned m = k[0], t;
    t = (unsigned)__builtin_amdgcn_update_dpp(0, (int)m, 0xB1, 0xf, 0xf, true); m = m > t ? m : t;
    t = (unsigned)__builtin_amdgcn_update_dpp(0, (int)m, 0x4E, 0xf, 0xf, true); m = m > t ? m : t;
    t = (unsigned)__builtin_amdgcn_update_dpp(0, (int)m, 0x141, 0xf, 0xf, true); m = m > t ? m : t;
    t = (unsigned)__builtin_amdgcn_update_dpp(0, (int)m, 0x140, 0xf, 0xf, true); m = m > t ? m : t;
    const bool win = k[0] == m;
#pragma unroll
    for (int i = 0; i < N - 1; ++i) k[i] = win ? k[i + 1] : k[i];
    k[N - 1] = win ? 0u : k[N - 1];
    res = (j16 == r) ? m : res;
  }
  return res;
}

enum { PH_PRO = 0, PH_E1, PH_E2, PH_E3, PH_E4, PH_E5, PH_E6, PH_MIXO, PH_LN1, PH_P1, PH_P2, PH_P3, PH_G2, PH_O1, PH_O2, PH_O3, PH_P3B };

struct PhaseDesc { int kind; int layer; };

__device__ __forceinline__ void run_phase(const Params& P, int kind, int L, char* lds, bool dry) {
  int tid_ = threadIdx.x, bid_ = blockIdx.x;
  asm volatile("" : "+v"(tid_));
  asm volatile("" : "+s"(bid_));
  const int tid = tid_, lane = tid & 63, w = tid >> 6;
  const int nb = gridDim.x, bid = bid_;
  const int xcd = bid & 7, li = bid >> 3, nloc = nb >> 3;
  char* ws = P.ws;
  bf16_t* Wb = (bf16_t*)(ws + OFF_W);
  unsigned char* tabU = (unsigned char*)(ws + OFF_TABU);
  unsigned char* tabV = (unsigned char*)(ws + OFF_TABU + 16 * MiB);
  float* sclU = (float*)(ws + OFF_MISC + 6 * MiB);
  float* sclV = sclU + 16384;
  float* Hf = (float*)(ws + OFF_H);
  bf16_t* hbA = (bf16_t*)(ws + OFF_HBA);
  bf16_t* hbB = (bf16_t*)(ws + OFF_HBB);
  bf16_t* RA = (bf16_t*)(ws + OFF_RA);
  char* RB = ws + OFF_RB;
  bf16_t* RO = (bf16_t*)(ws + OFF_RO);
  float* OD = (float*)(ws + OFF_OD);
  int* pe_idx = (int*)(ws + OFF_PK);
  float* pe_g = (float*)(ws + OFF_PK + 16 * MiB);
  char* MS = ws + OFF_MISC;
  float* cstab = (float*)(MS + MS_CS);
  float* lutB = (float*)(MS + MS_LUTB);
  float* lutC = (float*)(MS + MS_LUTC);
  int* pmm = (int*)(MS + MS_PMM);
  float* lamv = (float*)(MS + MS_LAM);
  float* rsq = (float*)(MS + MS_RSQ);
  float* rskv = (float*)(MS + MS_RSKV);
  const int j = L >> 1;
  const bf16_t* We = Wb + (size_t)j * WE_SZ;
  const bf16_t* Wo = Wb + WO_BASE + (size_t)j * WO_SZ;
  const bf16_t* Wl = Wb + WL_BASE + (size_t)L * WL_SZ;

  switch (kind) {
  case PH_PRO: {
    {
      int base = 0;
#pragma unroll 1
      for (int job = 0; job < 24; ++job) {
        const float* src; const float* gsc = nullptr; bf16_t* dst; int K, N, Np;
        if (job < 12) {
          const int jj = job / 6, k = job % 6;
          bf16_t* W = Wb + (size_t)jj * WE_SZ;
          bf16_t* W2 = Wb + WO_BASE + (size_t)jj * WO_SZ;
          if (k == 0) { src = P.ev_w_in + (size_t)jj * 1024 * 2336; K = 1024; N = 2336; Np = NE; dst = W + WE_IN; }
          else if (k == 1) { src = P.ev_w_uq + (size_t)jj * 512 * 768; K = 512; N = 768; Np = 768; dst = W + WE_UQ; gsc = P.ev_q_norm + jj * 512; }
          else if (k == 2) { src = P.ev_w_ukv + (size_t)jj * 256 * 1024; K = 256; N = 1024; Np = 1024; dst = W + WE_UKV; gsc = P.ev_kv_norm + jj * 256; }
          else if (k == 3) { src = P.ev_w_o + (size_t)jj * 1024 * 1024; K = 1024; N = 1024; Np = 1024; dst = W + WE_O; }
          else if (k == 4) { src = P.od_w_in + (size_t)jj * 1024 * 2640; K = 1024; N = 2640; Np = NO; dst = W2 + WO_IN; }
          else { src = P.od_w_o + (size_t)jj * 1024 * 1024; K = 1024; N = 1024; Np = 1024; dst = W2 + WO_O; }
        } else {
          const int l = (job - 12) / 3, k = (job - 12) % 3;
          bf16_t* W = Wb + WL_BASE + (size_t)l * WL_SZ;
          if (k == 0) { src = P.peer_w_q + (size_t)l * 1024 * 2048; K = 1024; N = 2048; Np = 2048; dst = W + WL_Q; }
          else if (k == 1) { src = P.ple_gate_w + (size_t)l * 1024 * 1024; K = 1024; N = 1024; Np = 1024; dst = W + WL_G; }
          else { src = P.ple_w + (size_t)l * 256 * 1024; K = 256; N = 1024; Np = 1024; dst = W + WL_PLE; }
        }
        const int n = (K >> 6) * (Np >> 6);
        for (int it = bid - base; it < n; it += nb) if (it >= 0) tconv_item(src, K, N, Np, dst, gsc, it, lds);
        base = (base + n) % nb;
      }
      for (int it = bid; it < 64; it += nb) {
        const int l = it >> 4, k = (it >> 3) & 1, i8 = it & 7;
        bf16_t* W = Wb + WL_BASE + (size_t)l * WL_SZ;
        conv_item((k ? P.peer_k2 : P.peer_k1) + (size_t)l * 16384, W + (k ? WL_K2 : WL_K1), i8);
      }
    }
    for (int it = bid; it < 16384; it += nb) conv_item(P.x, hbB, it);
    for (int it = bid; it < 2048; it += nb) {
      int idx = it * 256 + tid, t = idx >> 4, f = idx & 15;
      float freq = powf(10000.f, -(float)f / 16.f);
      float ang = (float)P.pos[t] * freq;
      float sn, cs;
      sincosf(ang, &sn, &cs);
      cstab[2 * idx] = cs; cstab[2 * idx + 1] = sn;
    }
    if (bid == 0) {
      for (int i = tid; i < 8 * 513; i += 256) { int hd = i / 513, r = i % 513; lutB[hd * 520 + r] = P.rel_bias[t5_bucket(r - 256) * 24 + hd] * L2E; }
      for (int i = tid; i < 16 * 513; i += 256) { int r = i >> 4, hd = i & 15; lutC[r * 16 + hd] = P.rel_bias[t5_bucket(r - 256) * 24 + 8 + hd] * L2E; }
      for (int i = tid; i < 512; i += 256) {
        int mn = 0x7fffffff, mx = -0x7fffffff;
        for (int k = 0; k < 64; ++k) { int v = P.pos[i * 64 + k]; mn = v < mn ? v : mn; mx = v > mx ? v : mx; }
        pmm[2 * i] = mn; pmm[2 * i + 1] = mx;
      }
      if (tid < 2) {
        float a = 0.f, b = 0.f;
        for (int k = 0; k < 32; ++k) { a += P.lq1[tid * 32 + k] * P.lk1[tid * 32 + k]; b += P.lq2[tid * 32 + k] * P.lk2[tid * 32 + k]; }
        float lam_init = 0.8f - 0.6f * expf(-0.3f * (float)(2 * tid));
        lamv[2 * tid] = expf(a) - expf(b) + lam_init;
        lamv[2 * tid + 1] = lam_init;
      }
    }
  } break;

  case PH_E1: {
    EpiEvenProj epi{RA, (bf16_t*)(RB + RB_VTD)};
    const int ntn = NE / 128;
#ifdef GEMM_EXP
    if (dry) {
      EpiEvenProj epd{(bf16_t*)OD, (bf16_t*)OD + 80 * MiB / 2};
      for (int it = bid; it < 128 * ntn; it += nb) gemm_tile<4, false, GEMM_EXP>(hbB, 1024, We + WE_IN, 1024, (it / ntn) * 256, (it % ntn) * 128, lds, epd);
      break;
    }
#endif
    for (int j = li; j < 16 * ntn; j += nloc) gemm_tile<4>(hbB, 1024, We + WE_IN, 1024, (xcd + 8 * (j / ntn)) * 256, (j % ntn) * 128, lds, epi);
  } break;

  case PH_E2: {
    for (int it = bid; it < T_ / 4; it += nb) {
      int t = it * 4 + w;
      const bf16_t* row = RA + (size_t)t * NE;
      u32x4 a = *(const u32x4*)(row + 8 * lane);
      float ss = 0.f;
#pragma unroll
      for (int e = 0; e < 4; ++e) { float lo = bf_lo(a[e]), hi = bf_hi(a[e]); ss += lo * lo + hi * hi; }
      ss = wave_sum(ss);
      u32x2 c = *(const u32x2*)(row + 512 + 4 * lane);
      float s2 = 0.f;
#pragma unroll
      for (int e = 0; e < 2; ++e) { float lo = bf_lo(c[e]), hi = bf_hi(c[e]); s2 += lo * lo + hi * hi; }
      s2 = wave_sum(s2);
      if (lane == 0) { rsq[t] = rsqrtf(ss / 512.f + 1e-6f); rskv[t] = rsqrtf(s2 / 256.f + 1e-6f); }
      if (lane < 16) {
        bf16_t* kr = RA + (size_t)t * NE + 768;
        float x1 = bf2f(kr[lane]), x2 = bf2f(kr[16 + lane]);
        float cs = cstab[(t * 16 + lane) * 2], sn = cstab[(t * 16 + lane) * 2 + 1];
        kr[lane] = f2bf(x1 * cs - x2 * sn);
        kr[16 + lane] = f2bf(x2 * cs + x1 * sn);
      }
    }
  } break;

  case PH_E3: {
    EpiRowScaleBf16 e1{(bf16_t*)(RB + RB_QA), 768, rsq};
    EpiKV e2{(bf16_t*)(RB + RB_KN), (bf16_t*)(RB + RB_VTA), rskv};
    const int n1 = 128 * 6, n2 = 128 * 8;
    int j = li;
    for (; j < 96; j += nloc) gemm_tile<4>(RA, NE, We + WE_UQ, 512, (xcd + 8 * (j / 6)) * 256, (j % 6) * 128, lds, e1);
    for (; j < 96 + 128; j += nloc) { int j2 = j - 96; gemm_tile<4>(RA + 512, NE, We + WE_UKV, 256, (xcd + 8 * (j2 >> 3)) * 256, (j2 & 7) * 128, lds, e2); }
  } break;

  case PH_E4: {
    bf16_t* qa = (bf16_t*)(RB + RB_QA);
    for (int it = bid; it < 16384; it += nb) {
      int idx = it * 256 + tid, t = idx >> 7, hd = (idx >> 4) & 7, f = idx & 15;
      bf16_t* q = qa + (size_t)t * 768 + hd * 96 + 64;
      float x1 = bf2f(q[f]), x2 = bf2f(q[16 + f]);
      float cs = cstab[(t * 16 + f) * 2], sn = cstab[(t * 16 + f) * 2 + 1];
      q[f] = f2bf(x1 * cs - x2 * sn);
      q[16 + f] = f2bf(x2 * cs + x1 * sn);
    }
  } break;

  case PH_E5: {
    const bf16_t* qa = (const bf16_t*)(RB + RB_QA);
    const bf16_t* kn = (const bf16_t*)(RB + RB_KN);
    const bf16_t* vTa = (const bf16_t*)(RB + RB_VTA);
    const bf16_t* vTd = (const bf16_t*)(RB + RB_VTD);
    for (int rr = li >> 5; rr < 24; rr += ((nloc >> 5) > 0 ? (nloc >> 5) : 1)) {
      const int combo = xcd + 8 * rr;
      const int qt = ((rr >> 1) & 1) ? (li & 31) : 31 - (li & 31);
      const int b = combo / 24, u = combo % 24;
      int tok0 = b * S_;
      if (u < 8) {
        attn_item<96, false>(qa + u * 96, 768, kn + u * 64, 512, RA + 768, NE, vTa + (size_t)((b * 8 + u) * 64) * S_,
                             P.pos + tok0, nullptr, pmm + b * 128, tok0, qt, 0.10206207261596577f * L2E, lds,
                             RO + u * 64, nullptr, 1024, cstab);
      } else {
        int hd = (u - 8) >> 1, m = (u - 8) & 1;
        attn_item<32, true>(RA + 800 + hd * 64 + m * 32, NE, RA + 1312 + hd * 64 + m * 32, NE, nullptr, 0,
                            vTd + (size_t)((b * 8 + hd) * 64) * S_, P.pos + tok0, lutB + hd * 520, pmm + b * 128, tok0, qt,
                            0.17677669529663687f * L2E, lds, nullptr, OD + (size_t)m * T_ * 512 + hd * 64, 512);
      }
    }
  } break;

  case PH_E6: {
    const float lam = lamv[2 * j], lam_init = lamv[2 * j + 1];
    for (int it = bid; it < 16384; it += nb) {
      int pair = it * 16 + (tid >> 4), t = pair >> 3, hd = pair & 7, d = (tid & 15) * 4;
      f32x4 o1 = *(const f32x4*)(OD + (size_t)t * 512 + hd * 64 + d);
      f32x4 o2 = *(const f32x4*)(OD + (size_t)T_ * 512 + (size_t)t * 512 + hd * 64 + d);
      f32x4 v = o1 - lam * o2;
      float ss = v[0] * v[0] + v[1] * v[1] + v[2] * v[2] + v[3] * v[3];
      ss = row16_sum(ss);
      float r = rsqrtf(ss / 64.f + 1e-6f) * (1.f - lam_init);
      const float* g = P.ev_subln + j * 64 + d;
      u32x2 pk = {pack_bf16(v[0] * r * g[0], v[1] * r * g[1]), pack_bf16(v[2] * r * g[2], v[3] * r * g[3])};
      *(u32x2*)(RO + (size_t)t * 1024 + 512 + hd * 64 + d) = pk;
    }
  } break;

  case PH_MIXO: {
    EpiResid epi{(bf16_t*)RB, L == 0 ? P.x : nullptr, hbB};
    const bf16_t* Wt = (L & 1) ? (Wo + WO_O) : (We + WE_O);
    const int n1 = 128 * 8;
    for (int j = li; j < 128; j += nloc) gemm_tile<4>(RO, 1024, Wt, 1024, (xcd + 8 * (j >> 3)) * 256, (j & 7) * 128, lds, epi);
    for (int it = bid; it < 4096; it += nb) conv_item(P.p + (size_t)L * T_ * 256, (bf16_t*)OD, it);
  } break;

  case PH_LN1: {
    const bf16_t* y = (const bf16_t*)RB;
    const float* g = P.ln1_g + L * 1024; const float* bb = P.ln1_b + L * 1024;
    for (int it = bid; it < T_ / 4; it += nb) {
      int t = it * 4 + w;
      f32x4 v[4]; float s = 0.f;
#pragma unroll
      for (int k = 0; k < 4; ++k) {
        const u32x2 yy = *(const u32x2*)(y + (size_t)t * 1024 + 256 * k + 4 * lane);
        v[k] = f32x4{bf_lo(yy[0]), bf_hi(yy[0]), bf_lo(yy[1]), bf_hi(yy[1])};
        s += v[k][0] + v[k][1] + v[k][2] + v[k][3];
      }
      float mu = wave_sum(s) * (1.f / 1024.f);
      float q = 0.f;
#pragma unroll
      for (int k = 0; k < 4; ++k) { v[k] -= mu; q += v[k][0] * v[k][0] + v[k][1] * v[k][1] + v[k][2] * v[k][2] + v[k][3] * v[k][3]; }
      float rstd = rsqrtf(wave_sum(q) * (1.f / 1024.f) + 1e-5f);
      if (lane == 0) { f32x2 st = {mu, rstd}; *(f32x2*)(MS + 8 * MiB + (size_t)t * 8) = st; }
#pragma unroll
      for (int k = 0; k < 4; ++k) {
        int c = 256 * k + 4 * lane;
        f32x4 gg = *(const f32x4*)(g + c), b4 = *(const f32x4*)(bb + c);
        f32x4 o = v[k] * rstd * gg + b4;
        u32x2 pk = {pack_bf16(o[0], o[1]), pack_bf16(o[2], o[3])};
        *(u32x2*)(hbA + (size_t)t * 1024 + c) = pk;
      }
    }
  } break;

  case PH_P1: {
    EpiBf16 e1{RA, 2048, 2048};
    EpiBf16 e2{RO, 1024, 1024};
    const int n1 = 128 * 16, n2 = 128 * 8, n3 = 4096;
    int j = li;
    for (; j < 256; j += nloc) gemm_tile<4>(hbA, 1024, Wl + WL_Q, 1024, (xcd + 8 * (j >> 4)) * 256, (j & 15) * 128, lds, e1);
    for (; j < 256 + 128; j += nloc) { int j2 = j - 256; gemm_tile<4>((const bf16_t*)OD, 256, Wl + WL_PLE, 256, (xcd + 8 * (j2 >> 3)) * 256, (j2 & 7) * 128, lds, e2); }
    for (int it = bid; it < n3; it += nb) convfp8_item(P.peer_u + (size_t)L * 16384 * 1024, tabU, sclU, it);
    for (int it = bid; it < n3; it += nb) convfp8_item(P.peer_v + (size_t)L * 16384 * 1024, tabV, sclV, it);
  } break;

  case PH_P2: {
    float* st = (float*)lds;
    EpiLds epi{st};
    const int j16 = lane & 15, rr = lane >> 4;
    int ccode[4];
#pragma unroll
    for (int m = 0; m < 4; ++m) {
      int n = j16 + 16 * m, code = 255;
      if (n < 50) {
        int a = 0;
        for (; a < 16; ++a) { int cnt = 16 / (a + 1); if (n < cnt) break; n -= cnt; }
        code = a * 16 + n;
      }
      ccode[m] = code;
    }
    unsigned* T1 = (unsigned*)pe_idx;
    unsigned* T2 = (unsigned*)pe_g;
    for (int it = bid; it < 2048; it += nb) {
      const int mt = it >> 3, hd = it & 7;
#pragma unroll 1
      for (int half = 0; half < 2; ++half) {
        gemm_tile<2, true>(RA + hd * 256 + half * 128, 2048, Wl + (half ? WL_K2 : WL_K1), 128, mt * 128, 0, lds, epi);
        __syncthreads();
        unsigned* Th = half ? T2 : T1;
#pragma unroll 1
        for (int tk = 0; tk < 8; ++tk) {
          const int row = (w * 8 + tk) * 4 + rr;
          unsigned k[8];
#pragma unroll
          for (int m = 0; m < 8; ++m) {
            const int c = j16 + 16 * m;
            k[m] = (mono_key(st[row * 128 + ((c + row) & 127)]) & ~127u) | (unsigned)(127 - c);
          }
          sort8_desc(k);
          Th[(size_t)(mt * 128 + row) * 128 + hd * 16 + j16] = dpp_top16<8>(k, j16);
        }
        __syncthreads();
      }
#pragma unroll 1
      for (int tk = 0; tk < 8; ++tk) {
        const int row = (w * 8 + tk) * 4 + rr;
        const size_t obase = (size_t)(mt * 128 + row) * 128 + hd * 16;
        unsigned k[4];
#pragma unroll
        for (int m = 0; m < 4; ++m) {
          const int code = ccode[m];
          const float va = key_val(T1[obase + ((code >> 4) & 15)] & ~127u);
          const float vb = key_val(T2[obase + (code & 15)] & ~127u);
          k[m] = code < 255 ? ((mono_key(va + vb) & ~255u) | (unsigned)(255 - code)) : 0u;
        }
        sort4_desc(k);
        const unsigned kk = dpp_top16<4>(k, j16);
        const int code = 255 - (int)(kk & 255u);
        const float v = key_val(kk & ~255u);
        float mx = v;
        mx = fmaxf(mx, __builtin_bit_cast(float, __builtin_amdgcn_update_dpp(0, __builtin_bit_cast(int, mx), 0xB1, 0xf, 0xf, true)));
        mx = fmaxf(mx, __builtin_bit_cast(float, __builtin_amdgcn_update_dpp(0, __builtin_bit_cast(int, mx), 0x4E, 0xf, 0xf, true)));
        mx = fmaxf(mx, __builtin_bit_cast(float, __builtin_amdgcn_update_dpp(0, __builtin_bit_cast(int, mx), 0x141, 0xf, 0xf, true)));
        mx = fmaxf(mx, __builtin_bit_cast(float, __builtin_amdgcn_update_dpp(0, __builtin_bit_cast(int, mx), 0x140, 0xf, 0xf, true)));
        const float e = __expf(v - mx);
        const float sum = row16_sum(e);
        const int i1 = 127 - (int)(T1[obase + (code >> 4)] & 127u);
        const int i2 = 127 - (int)(T2[obase + (code & 15)] & 127u);
        pe_idx[obase + j16] = i1 * 128 + i2;
        pe_g[obase + j16] = e / sum;
      }
    }
  } break;

  case PH_P3:
  case PH_P3B: {
    const bool st1 = kind == PH_P3;
    float* cbuf = OD + 4 * 1024 * 1024;
    int* idx_s = (int*)lds + w * 640;
    float* g_s = (float*)(idx_s + 128);
    float* c_s = (float*)(idx_s + 256);
    float* su_s = (float*)(idx_s + 384);
    float* sv_s = (float*)(idx_s + 512);
    const float* g2 = P.ln2_g + L * 1024; const float* b2 = P.ln2_b + L * 1024;
    const int jl = lane & 15, grp = lane >> 4;
    for (int it = bid; it < T_ / 4; it += nb) {
      const int t = it * 4 + w;
      idx_s[lane] = pe_idx[(size_t)t * 128 + lane]; idx_s[64 + lane] = pe_idx[(size_t)t * 128 + 64 + lane];
      if (!st1) {
        c_s[lane] = cbuf[(size_t)t * 128 + lane]; c_s[64 + lane] = cbuf[(size_t)t * 128 + 64 + lane];
      }
      if (st1) {
      g_s[lane] = pe_g[(size_t)t * 128 + lane]; g_s[64 + lane] = pe_g[(size_t)t * 128 + 64 + lane];
      u32x4 xq[4][2];
#pragma unroll
      for (int i = 0; i < 4; ++i) {
        xq[i][0] = *(const u32x4*)(hbA + (size_t)t * 1024 + 256 * i + 16 * jl);
        xq[i][1] = *(const u32x4*)(hbA + (size_t)t * 1024 + 256 * i + 16 * jl + 8);
      }
      su_s[lane] = sclU[idx_s[lane]]; su_s[64 + lane] = sclU[idx_s[64 + lane]];
      sv_s[lane] = sclV[idx_s[lane]]; sv_s[64 + lane] = sclV[idx_s[64 + lane]];
      auto ld1 = [&](u32x4 (&u)[4], int k4) {
        const unsigned char* ur = tabU + (size_t)idx_s[4 * k4 + grp] * 1024 + 16 * jl;
#pragma unroll
        for (int i = 0; i < 4; ++i) u[i] = *(const u32x4*)(ur + 256 * i);
      };
      auto cp1 = [&](const u32x4 (&u)[4], int k4) {
        float acc = 0.f;
#pragma unroll
        for (int i = 0; i < 4; ++i) {
#pragma unroll
          for (int k = 0; k < 4; ++k) {
            bf16x2v lo = __builtin_amdgcn_cvt_scalef32_pk_bf16_fp8((int)u[i][k], 1.0f, false);
            bf16x2v hi = __builtin_amdgcn_cvt_scalef32_pk_bf16_fp8((int)u[i][k], 1.0f, true);
            unsigned x0 = xq[i][k >> 1][(2 * k) & 3], x1 = xq[i][k >> 1][(2 * k + 1) & 3];
            acc = __builtin_amdgcn_fdot2_f32_bf16(lo, __builtin_bit_cast(bf16x2v, x0), acc, false);
            acc = __builtin_amdgcn_fdot2_f32_bf16(hi, __builtin_bit_cast(bf16x2v, x1), acc, false);
          }
        }
        acc = row16_sum(acc) * su_s[4 * k4 + grp];
        float x3 = acc * acc * acc;
        float z = 0.7978845608028654f * (acc + 0.044715f * x3);
        float ez = __expf(2.f * z);
        float th = 1.f - 2.f / (ez + 1.f);
        float ge = 0.5f * acc * (1.f + th);
        if (jl == 0) c_s[4 * k4 + grp] = g_s[4 * k4 + grp] * ge * sv_s[4 * k4 + grp];
      };
      {
        u32x4 u0[4], u1[4], u2[4];
        ld1(u0, 0); ld1(u1, 1);
#pragma unroll 1
        for (int k4 = 0; k4 < 30; k4 += 3) {
          ld1(u2, k4 + 2); cp1(u0, k4);
          ld1(u0, k4 + 3); cp1(u1, k4 + 1);
          ld1(u1, k4 + 4); cp1(u2, k4 + 2);
        }
        cp1(u0, 30); cp1(u1, 31);
      }
      cbuf[(size_t)t * 128 + lane] = c_s[lane]; cbuf[(size_t)t * 128 + 64 + lane] = c_s[64 + lane];
      continue;
      }
      float out[16];
#pragma unroll
      for (int i = 0; i < 16; ++i) out[i] = 0.f;
      auto ld2 = [&](u32x4 (&v)[8], int kb) {
#pragma unroll
        for (int k = 0; k < 8; ++k) v[k] = *(const u32x4*)(tabV + (size_t)idx_s[8 * kb + k] * 1024 + 16 * lane);
      };
      auto cp2 = [&](const u32x4 (&v)[8], int kb) {
#pragma unroll
        for (int k = 0; k < 8; ++k) {
          const float c = c_s[8 * kb + k];
#pragma unroll
          for (int e = 0; e < 4; ++e) {
            f32x2 lo = __builtin_amdgcn_cvt_pk_f32_fp8((int)v[k][e], false);
            f32x2 hi = __builtin_amdgcn_cvt_pk_f32_fp8((int)v[k][e], true);
            out[4 * e] = fmaf(c, lo[0], out[4 * e]); out[4 * e + 1] = fmaf(c, lo[1], out[4 * e + 1]);
            out[4 * e + 2] = fmaf(c, hi[0], out[4 * e + 2]); out[4 * e + 3] = fmaf(c, hi[1], out[4 * e + 3]);
          }
        }
      };
      {
        u32x4 v0[8], v1[8];
        ld2(v0, 0);
#pragma unroll 1
        for (int kb = 0; kb < 16; kb += 2) {
          ld2(v1, kb + 1); cp2(v0, kb);
          if (kb + 2 < 16) ld2(v0, kb + 2);
          cp2(v1, kb + 1);
        }
      }
      float* hr = Hf + (size_t)t * 1024 + 16 * lane;
      float* hw = hr;
      const f32x2 st1v = *(const f32x2*)(MS + 8 * MiB + (size_t)t * 8);
      bf16_t* hbw = (dry ? RA : hbA) + (size_t)t * 1024 + 16 * lane;
      float s = 0.f;
#pragma unroll
      for (int k = 0; k < 4; ++k) {
        const u32x2 yy = *(const u32x2*)((const bf16_t*)RB + (size_t)t * 1024 + 16 * lane + 4 * k);
        const f32x4 yv = {bf_lo(yy[0]), bf_hi(yy[0]), bf_lo(yy[1]), bf_hi(yy[1])};
        const f32x4 g1 = *(const f32x4*)(P.ln1_g + L * 1024 + 16 * lane + 4 * k);
        const f32x4 b1 = *(const f32x4*)(P.ln1_b + L * 1024 + 16 * lane + 4 * k);
        const f32x4 a = (yv - st1v[0]) * st1v[1] * g1 + b1;
#pragma unroll
        for (int e = 0; e < 4; ++e) { out[4 * k + e] += DN_ALPHA * a[e]; s += out[4 * k + e]; }
      }
      float mu = wave_sum(s) * (1.f / 1024.f);
      float q = 0.f;
#pragma unroll
      for (int i = 0; i < 16; ++i) { out[i] -= mu; q += out[i] * out[i]; }
      float rstd = rsqrtf(wave_sum(q) * (1.f / 1024.f) + 1e-5f);
      unsigned pk[8];
#pragma unroll
      for (int k = 0; k < 4; ++k) {
        f32x4 ga = *(const f32x4*)(g2 + 16 * lane + 4 * k), ba = *(const f32x4*)(b2 + 16 * lane + 4 * k);
        f32x4 oa;
#pragma unroll
        for (int e = 0; e < 4; ++e) oa[e] = out[4 * k + e] * rstd * ga[e] + ba[e];
        pk[2 * k] = pack_bf16(oa[0], oa[1]); pk[2 * k + 1] = pack_bf16(oa[2], oa[3]);
      }
      u32x4 p0 = {pk[0], pk[1], pk[2], pk[3]}, p1 = {pk[4], pk[5], pk[6], pk[7]};
      *(u32x4*)hbw = p0; *(u32x4*)(hbw + 8) = p1;
    }
  } break;

  case PH_G2: {
    EpiGate epi{hbA, dry ? (float*)RB : (L == 3 ? P.out : nullptr), dry ? RA : hbB, RO, P.ple_gate_b + L * 1024};
    for (int j = li; j < 128; j += nloc) gemm_tile<4>(hbA, 1024, Wl + WL_G, 1024, (xcd + 8 * (j >> 3)) * 256, (j & 7) * 128, lds, epi);
  } break;

  case PH_O1: {
    EpiBf16 epi{RA, NO, 2640};
    const int ntn = NO / 128;
    for (int j = li; j < 16 * ntn; j += nloc) gemm_tile<4>(hbB, 1024, Wo + WO_IN, 1024, (xcd + 8 * (j / ntn)) * 256, (j % ntn) * 128, lds, epi);
  } break;

  case PH_O2: {
    {
      unsigned char* kv8 = (unsigned char*)(RB + 128 * MiB);
      for (int it = bid; it < 8192; it += nb) {
        const int idx = it * 256 + tid, t = idx >> 6, e8 = idx & 63;
        const u32x4 v = *(const u32x4*)(RA + (size_t)t * NO + 1024 + 8 * e8);
        int p0 = 0, p1 = 0;
        p0 = __builtin_amdgcn_cvt_pk_fp8_f32(bf_lo(v[0]), bf_hi(v[0]), p0, false);
        p0 = __builtin_amdgcn_cvt_pk_fp8_f32(bf_lo(v[1]), bf_hi(v[1]), p0, true);
        p1 = __builtin_amdgcn_cvt_pk_fp8_f32(bf_lo(v[2]), bf_hi(v[2]), p1, false);
        p1 = __builtin_amdgcn_cvt_pk_fp8_f32(bf_lo(v[3]), bf_hi(v[3]), p1, true);
        u32x2 o = {(unsigned)p0, (unsigned)p1};
        *(u32x2*)(kv8 + (size_t)t * 512 + 8 * e8) = o;
      }
    }
    for (int it = bid; it < 34816; it += nb) {
      int idx = it * 256 + tid, t = idx / 272, r = idx % 272, hd = r >> 4, f = r & 15;
      bf16_t* q = RA + (size_t)t * NO + (hd < 16 ? 1536 + hd * 64 : 2560);
      float x1 = bf2f(q[f]), x2 = bf2f(q[16 + f]);
      float cs = cstab[(t * 16 + f) * 2], sn = cstab[(t * 16 + f) * 2 + 1];
      q[f] = f2bf(x1 * cs - x2 * sn);
      q[16 + f] = f2bf(x2 * cs + x1 * sn);
    }
  } break;

  case PH_O3: {
    float* scr = (float*)RB + (size_t)bid * 16 * 4096;
    char* qi_s = lds;
    float* w_s = (float*)(lds + 33024);
    int* sel = (int*)lds + w * 256;
    bf16_t* q_s = (bf16_t*)(lds + 4096) + w * 1024;
    float* p_s = (float*)(lds + 12288) + w * 1024;
    int* rel_s = (int*)(lds + 28672) + w * 256;
    const unsigned char* kv8 = (const unsigned char*)(RB + 128 * MiB);
    for (int it = bid; it < 2048; it += nb) {
      const int g8 = it >> 3, kq4 = g8 >> 6, m64 = g8 & 63;
      const int qtile = 255 - 64 * kq4 - ((kq4 & 1) ? 63 - m64 : m64), b = it & 7;
      const int q0 = qtile * 16, tok0 = b * S_;
      const int nk = 64 * ((q0 >> 6) + 1);
      __syncthreads();
#pragma unroll
      for (int i = 0; i < 8; ++i) {
        int p = tid + 256 * i, q = p >> 7, c = p & 127;
        *(u32x4*)(qi_s + q * 2064 + c * 16) = *(const u32x4*)(RA + (size_t)(tok0 + q0 + q) * NO + 1536 + 8 * c);
      }
      { int q = tid >> 4, hd = tid & 15; w_s[hd * 16 + q] = bf2f(RA[(size_t)(tok0 + q0 + q) * NO + 2624 + hd]) * (0.25f * 0.125f); }
      __syncthreads();
      const int l15 = lane & 15, kq = lane >> 4;
      if (nk > 256)
      for (int kc = w; kc < (nk >> 6); kc += 4) {
        const int k0 = kc * 64;
        bf16x8 kf[4][2];
#pragma unroll
        for (int tl = 0; tl < 4; ++tl)
#pragma unroll
          for (int s = 0; s < 2; ++s)
            kf[tl][s] = *(const bf16x8*)(RA + (size_t)(tok0 + k0 + 16 * tl + l15) * NO + 2560 + 32 * s + 8 * kq);
        f32x4 sc[4];
#pragma unroll
        for (int tl = 0; tl < 4; ++tl) sc[tl] = f32x4{0.f, 0.f, 0.f, 0.f};
#pragma unroll 1
        for (int hd = 0; hd < 16; ++hd) {
          bf16x8 a0 = *(const bf16x8*)(qi_s + l15 * 2064 + hd * 128 + kq * 16);
          bf16x8 a1 = *(const bf16x8*)(qi_s + l15 * 2064 + hd * 128 + 64 + kq * 16);
          f32x4 wv = *(const f32x4*)(w_s + hd * 16 + 4 * kq);
#pragma unroll
          for (int tl = 0; tl < 4; ++tl) {
            f32x4 d = f32x4{0.f, 0.f, 0.f, 0.f};
            d = mfma16(a0, kf[tl][0], d);
            d = mfma16(a1, kf[tl][1], d);
#pragma unroll
            for (int jj = 0; jj < 4; ++jj) sc[tl][jj] = fmaf(wv[jj], fmaxf(d[jj], 0.f), sc[tl][jj]);
          }
        }
#pragma unroll
        for (int tl = 0; tl < 4; ++tl)
#pragma unroll
          for (int jj = 0; jj < 4; ++jj) __builtin_nontemporal_store(sc[tl][jj], scr + (4 * kq + jj) * 4096 + k0 + 16 * tl + l15);
      }
      __syncthreads();
      for (int qq = 0; qq < 4; ++qq) {
        const int q = 4 * w + qq, tok = tok0 + q0 + q;
        int nvalid;
        if (nk <= 256) {
#pragma unroll
          for (int r = 0; r < 4; ++r) { int slot = lane + 64 * r; if (slot < nk) sel[slot] = slot; }
          nvalid = nk;
        } else {
          const int nreg = nk >> 6;
          unsigned key[64];
#pragma unroll
          for (int r4 = 0; r4 < 16; ++r4) {
            const u32x4 v = __builtin_nontemporal_load((const u32x4*)(scr + q * 4096 + 256 * r4 + 4 * lane));
            key[4 * r4] = v[0]; key[4 * r4 + 1] = v[1]; key[4 * r4 + 2] = v[2]; key[4 * r4 + 3] = v[3];
          }
#pragma unroll
          for (int r = 0; r < 64; ++r) {
            const unsigned u = key[r];
            const unsigned kk = (u & 0x80000000u) ? ~u : (u | 0x80000000u);
            key[r] = (256 * (r >> 2) + 4 * lane < nk) ? kk : 0u;
          }
          unsigned prefix = 0;
          for (int bit = 31; bit >= 0; --bit) {
            const unsigned cand = prefix | (1u << bit);
            int cl = 0;
#pragma unroll
            for (int g8 = 0; g8 < 8; ++g8) {
              if (8 * g8 < nreg) {
#pragma unroll
                for (int r = 8 * g8; r < 8 * g8 + 8; ++r) cl += (key[r] >= cand) ? 1 : 0;
              }
            }
            cl += __builtin_amdgcn_update_dpp(0, cl, 0xB1, 0xf, 0xf, true);
            cl += __builtin_amdgcn_update_dpp(0, cl, 0x4E, 0xf, 0xf, true);
            cl += __builtin_amdgcn_update_dpp(0, cl, 0x141, 0xf, 0xf, true);
            cl += __builtin_amdgcn_update_dpp(0, cl, 0x140, 0xf, 0xf, true);
            const int cnt = __builtin_amdgcn_readlane(cl, 0) + __builtin_amdgcn_readlane(cl, 16) +
                            __builtin_amdgcn_readlane(cl, 32) + __builtin_amdgcn_readlane(cl, 48);
            if (cnt == 256) { prefix = cand - 1u; break; }
            if (cnt > 256) prefix = cand;
          }
          int cgt = 0;
#pragma unroll
          for (int g8 = 0; g8 < 8; ++g8) {
            if (8 * g8 < nreg) {
#pragma unroll
              for (int r = 8 * g8; r < 8 * g8 + 8; ++r) cgt += __popcll(__ballot(key[r] > prefix));
            }
          }
          const int need = 256 - cgt;
          int base = 0, eqc = 0;
          const unsigned long long ltmask = (1ull << lane) - 1ull;
#pragma unroll
          for (int g8 = 0; g8 < 8; ++g8) {
            if (8 * g8 < nreg) {
#pragma unroll
              for (int r = 8 * g8; r < 8 * g8 + 8; ++r) {
                bool gt = key[r] > prefix, eq = key[r] == prefix;
                unsigned long long meq = __ballot(eq);
                int eqb = eqc + __popcll(meq & ltmask);
                bool take = gt || (eq && eqb < need);
                unsigned long long mt = __ballot(take);
                if (take) sel[base + __popcll(mt & ltmask)] = 256 * (r >> 2) + 4 * lane + (r & 3);
                base += __popcll(mt);
                eqc += __popcll(meq);
              }
            }
          }
          nvalid = 256;
        }
        const int posq = P.pos[tok];
        {
          const bf16_t* qg = RA + (size_t)tok * NO + 16 * lane;
          *(u32x4*)(q_s + 16 * lane) = *(const u32x4*)qg;
          *(u32x4*)(q_s + 16 * lane + 8) = *(const u32x4*)(qg + 8);
        }
        auto ldk = [&](u32x4 (&kr)[4], int g, int jj) {
          const int slot = lane + 64 * jj;
          const int key = slot < nvalid ? sel[slot] : 0;
          const unsigned char* krow = kv8 + (size_t)(tok0 + key) * 512 + g * 64;
#pragma unroll
          for (int c = 0; c < 4; ++c) kr[c] = *(const u32x4*)(krow + 16 * c);
        };
#pragma unroll
        for (int jj = 0; jj < 4; ++jj) {
          const int slot = lane + 64 * jj;
          const int key = slot < nvalid ? sel[slot] : 0;
          int rel = P.pos[tok0 + key] - posq;
          rel_s[slot] = (min(max(rel, -256), 256) + 256) * 16;
        }
        u32x4 kcur[4];
        ldk(kcur, 0, 0);
#pragma unroll 1
        for (int g = 0; g < 4; ++g) {
#pragma unroll 1
          for (int jj = 0; jj < 4; ++jj) {
            const int slot = lane + 64 * jj;
            const bool valid = slot < nvalid;
            const f32x4 bias = *(const f32x4*)(lutC + rel_s[slot] + g * 4);
            u32x4 knxt[4];
            {
              int gn = g, jn = jj + 1;
              if (jn == 4) { jn = 0; gn = g + 1; }
              if (gn < 4) ldk(knxt, gn, jn);
            }
            unsigned kb[32];
#pragma unroll
            for (int d = 0; d < 16; ++d) {
              kb[2 * d] = __builtin_bit_cast(unsigned, __builtin_amdgcn_cvt_scalef32_pk_bf16_fp8((int)kcur[d >> 2][d & 3], 1.0f, false));
              kb[2 * d + 1] = __builtin_bit_cast(unsigned, __builtin_amdgcn_cvt_scalef32_pk_bf16_fp8((int)kcur[d >> 2][d & 3], 1.0f, true));
            }
            f32x4 tv;
#pragma unroll
            for (int hh = 0; hh < 4; ++hh) {
              float a0 = 0.f, a1 = 0.f;
#pragma unroll
              for (int c4 = 0; c4 < 8; c4 += 4) {
                u32x4 qv[4];
#pragma unroll
                for (int c = 0; c < 4; ++c) qv[c] = *(const u32x4*)(q_s + (g * 4 + hh) * 64 + 8 * (c4 + c));
#pragma unroll
                for (int c = 0; c < 4; c += 2) {
                  a0 = dot2(kb[4 * (c4 + c) + 0], qv[c][0], a0); a1 = dot2(kb[4 * (c4 + c + 1) + 0], qv[c + 1][0], a1);
                  a0 = dot2(kb[4 * (c4 + c) + 1], qv[c][1], a0); a1 = dot2(kb[4 * (c4 + c + 1) + 1], qv[c + 1][1], a1);
                  a0 = dot2(kb[4 * (c4 + c) + 2], qv[c][2], a0); a1 = dot2(kb[4 * (c4 + c + 1) + 2], qv[c + 1][2], a1);
                  a0 = dot2(kb[4 * (c4 + c) + 3], qv[c][3], a0); a1 = dot2(kb[4 * (c4 + c + 1) + 3], qv[c + 1][3], a1);
                }
              }
              tv[hh] = valid ? fmaf(a0 + a1, 0.125f * L2E, bias[hh]) : -INFINITY;
            }
            *(f32x4*)(p_s + slot * 4) = tv;
#pragma unroll
            for (int c = 0; c < 4; ++c) kcur[c] = knxt[c];
          }
          f32x4 sc4[4];
#pragma unroll
          for (int jj = 0; jj < 4; ++jj) sc4[jj] = *(const f32x4*)(p_s + (lane + 64 * jj) * 4);
          float inv[4];
#pragma unroll
          for (int hh = 0; hh < 4; ++hh) {
            float mx = fmaxf(fmaxf(sc4[0][hh], sc4[1][hh]), fmaxf(sc4[2][hh], sc4[3][hh]));
            mx = wave_max(mx);
            float sm = 0.f;
#pragma unroll
            for (int jj = 0; jj < 4; ++jj) { sc4[jj][hh] = __builtin_amdgcn_exp2f(sc4[jj][hh] - mx); sm += sc4[jj][hh]; }
            sm = wave_sum(sm);
            inv[hh] = 1.f / sm;
          }
#pragma unroll
          for (int jj = 0; jj < 4; ++jj) {
            f32x4 pv = {sc4[jj][0] * inv[0], sc4[jj][1] * inv[1], sc4[jj][2] * inv[2], sc4[jj][3] * inv[3]};
            *(f32x4*)(p_s + (lane + 64 * jj) * 4) = pv;
          }
          const int ks = lane >> 3, dc = lane & 7;
          f32x2 oa[4][4];
#pragma unroll
          for (int hh = 0; hh < 4; ++hh)
#pragma unroll
            for (int d = 0; d < 4; ++d) oa[hh][d] = f32x2{0.f, 0.f};
          const unsigned char* vbase = kv8 + (size_t)tok0 * 512 + 256 + g * 64 + 8 * dc;
          auto ldv = [&](u32x2& v, int i) {
            const int slot = 8 * i + ks;
            v = *(const u32x2*)(vbase + (size_t)sel[slot < nvalid ? slot : 0] * 512);
          };
          auto cpv = [&](const u32x2& v, int i) {
            const f32x4 pv = *(const f32x4*)(p_s + (8 * i + ks) * 4);
            f32x2 vv[4];
            vv[0] = __builtin_amdgcn_cvt_pk_f32_fp8((int)v[0], false); vv[1] = __builtin_amdgcn_cvt_pk_f32_fp8((int)v[0], true);
            vv[2] = __builtin_amdgcn_cvt_pk_f32_fp8((int)v[1], false); vv[3] = __builtin_amdgcn_cvt_pk_f32_fp8((int)v[1], true);
#pragma unroll
            for (int e = 0; e < 4; ++e) {
#pragma unroll
              for (int hh = 0; hh < 4; ++hh) oa[hh][e] = __builtin_elementwise_fma(f32x2{pv[hh], pv[hh]}, vv[e], oa[hh][e]);
            }
          };
          const int nit = nvalid >> 3;
          u32x2 vr[8];
#pragma unroll
          for (int k = 0; k < 7; ++k) ldv(vr[k], k);
#pragma unroll 1
          for (int i = 0; i < nit; i += 8) {
#pragma unroll
            for (int k = 0; k < 8; ++k) {
              if (i + k + 7 < nit) ldv(vr[(k + 7) & 7], i + k + 7);
              cpv(vr[k], i + k);
            }
          }
#pragma unroll
          for (int hh = 0; hh < 4; ++hh)
#pragma unroll
            for (int d = 0; d < 4; ++d)
#pragma unroll
              for (int z = 0; z < 2; ++z) {
                float a = oa[hh][d][z];
                a += __shfl_xor(a, 8); a += __shfl_xor(a, 16); a += __shfl_xor(a, 32);
                oa[hh][d][z] = a;
              }
          if (ks == 0) {
#pragma unroll
            for (int hh = 0; hh < 4; ++hh) {
              u32x4 pk = {pack_bf16(oa[hh][0][0], oa[hh][0][1]), pack_bf16(oa[hh][1][0], oa[hh][1][1]), pack_bf16(oa[hh][2][0], oa[hh][2][1]), pack_bf16(oa[hh][3][0], oa[hh][3][1])};
              *(u32x4*)(RO + (size_t)tok * 1024 + (g * 4 + hh) * 64 + 8 * dc) = pk;
            }
          }
        }
      }
    }
  } break;
  default: break;
  }
}

#define XB_TMO      128
#define XB_XCNT(j)  (256  + 64 * (j))
#define XB_XSUB(j)  (1280 + 64 * (j))
#define XB_XGEN(j)  (2304 + 64 * (j))
#define XB_TOP      3328
#define XB_TOPGEN   3392
#define XCD_BAR_WORDS 3456
#define XB_SPIN_CAP (1u << 20)
#define LAS __attribute__((address_space(3)))
DI unsigned xb_ld(unsigned* p)              { return __hip_atomic_load(p, __ATOMIC_RELAXED, __HIP_MEMORY_SCOPE_AGENT); }
DI unsigned xb_add(unsigned* p, unsigned v) { return __hip_atomic_fetch_add(p, v, __ATOMIC_RELAXED, __HIP_MEMORY_SCOPE_AGENT); }
DI unsigned xb_xcc_id() { return (unsigned)__builtin_amdgcn_s_getreg((3 << 11) | 20) & 0xFu; }
#define XB_SPIN(cond, bar) do { unsigned _sp = 0; while (cond) { __builtin_amdgcn_s_sleep(1); \
    if ((++_sp & 255u) == 0u) { if (xb_ld(&(bar)[XB_TMO])) break; if (_sp > XB_SPIN_CAP) { atomicAdd(&(bar)[XB_TMO], 1u); break; } } } } while (0)
struct XcdBarrier { unsigned* bar; unsigned x; volatile LAS unsigned* st; };
DI XcdBarrier xcd_barrier_post(unsigned* bar, volatile LAS unsigned* st) {
  XcdBarrier b; b.bar = bar; b.x = xb_xcc_id(); b.st = st;
  if (threadIdx.x == 0) (void)xb_add(&bar[XB_XCNT(b.x)], 1u);
  return b;
}
DI void xcd_barrier_complete(unsigned* bar, unsigned x, unsigned& nloc, unsigned& nx) {
  const unsigned G = gridDim.x * gridDim.y * gridDim.z;
  unsigned sum, cnt, mine, sp = 0u;
  for (;;) {
    sum = 0u; cnt = 0u; mine = 0u;
#pragma unroll
    for (unsigned j = 0; j < 16; ++j) { const unsigned c = xb_ld(&bar[XB_XCNT(j)]); sum += c; cnt += (c > 0u) ? 1u : 0u; mine = (j == x) ? c : mine; }
    if (sum == G) break;
    __builtin_amdgcn_s_sleep(1);
    if ((++sp & 255u) == 0u) { if (xb_ld(&bar[XB_TMO])) break; if (sp > XB_SPIN_CAP) { atomicAdd(&bar[XB_TMO], 1u); break; } }
  }
  nloc = mine > 0u ? mine : 1u; nx = cnt > 0u ? cnt : 1u;
}
DI void xcd_barrier(const XcdBarrier& b) {
  asm volatile("s_waitcnt vmcnt(0)" ::: "memory");
  __syncthreads();
  if (threadIdx.x == 0) {
    unsigned* bar = b.bar;
    __builtin_amdgcn_s_waitcnt(0);
    unsigned nloc = b.st[0], nx = b.st[1];
    if (nloc == 0u) { xcd_barrier_complete(bar, b.x, nloc, nx); b.st[0] = nloc; b.st[1] = nx; }
    const unsigned old = xb_add(&bar[XB_XSUB(b.x)], 1u);
    const unsigned gen = old / nloc;
    if (old + 1u == (gen + 1u) * nloc) {
      __builtin_amdgcn_fence(__ATOMIC_RELEASE, "agent");
      asm volatile("s_waitcnt vmcnt(0)" ::: "memory");
      const unsigned og = xb_add(&bar[XB_TOP], 1u);
      const unsigned tg = og / nx;
      if (og + 1u == (tg + 1u) * nx) xb_add(&bar[XB_TOPGEN], 1u);
      else XB_SPIN(xb_ld(&bar[XB_TOPGEN]) == tg, bar);
      __builtin_amdgcn_fence(__ATOMIC_ACQUIRE, "agent");
      xb_add(&bar[XB_XGEN(b.x)], 1u);
      asm volatile("s_waitcnt vmcnt(0)" ::: "memory");
    } else {
      XB_SPIN(xb_ld(&bar[XB_XGEN(b.x)]) == gen, bar);
      __builtin_amdgcn_fence(__ATOMIC_ACQUIRE, "agent");
      asm volatile("s_waitcnt vmcnt(0)" ::: "memory");
    }
  }
  __syncthreads();
}

DI void decode_phase(int ph, int& kind, int& layer) {
  if (ph == 0) { kind = PH_PRO; layer = 0; return; }
  int p = ph - 1;
  if (p < 12) layer = 0; else if (p < 22) { layer = 1; p -= 12; } else if (p < 34) { layer = 2; p -= 22; } else { layer = 3; p -= 34; }
  const int nmix = (layer & 1) ? 3 : 5;
  if (p < nmix) {
    kind = (layer & 1) ? PH_O1 + p : (p < 3 ? PH_E1 + p : PH_E5 + (p - 3));
    return;
  }
  const int q = p - nmix;
  kind = q < 5 ? PH_MIXO + q : (q == 5 ? PH_P3B : PH_G2);
}

constexpr size_t MS_BAR = 7 * MiB;
__global__ void __launch_bounds__(256, 2) megakernel(Params P) {
  __shared__ __attribute__((aligned(16))) char lds[65536];
  __shared__ uint4 xb_words;
  if (threadIdx.x == 0) xb_words = make_uint4(0u, 0u, 0u, 0u);
  __syncthreads();
  XcdBarrier xb = xcd_barrier_post((unsigned*)(P.ws + OFF_MISC + MS_BAR), (volatile LAS unsigned*)&xb_words);
  for (int ph = P.ph0; ph < P.ph1; ++ph) {
    int kind, layer;
    decode_phase(ph, kind, layer);
#ifdef ONLY_PHASE
    kind = ONLY_PHASE;
#endif
#ifdef DUP_MASK
    if ((DUP_MASK >> kind) & 1) {
#ifndef DUP_NOP
      run_phase(P, kind, layer, lds, true);
#endif
      xcd_barrier(xb);
    }
#endif
    run_phase(P, kind, layer, lds, false);
    if (ph + 1 < P.ph1) {
      if (ph == P.ph0) cg::this_grid().sync();
      else xcd_barrier(xb);
    }
  }
}

extern "C" void kernel_launch(void* const* d_in, const int* in_sizes, int n_in, void* d_out, int out_size, void* d_ws,
                              size_t ws_size, hipStream_t stream) {
  static int grid_blocks = 0;
  const int nph = 45;
  if (!grid_blocks) {
    int dev = 0, cus = 0, per_cu = 0;
    hipGetDevice(&dev);
    hipDeviceGetAttribute(&cus, hipDeviceAttributeMultiprocessorCount, dev);
    hipOccupancyMaxActiveBlocksPerMultiprocessor(&per_cu, megakernel, 256, 0);
    if (per_cu > 2) per_cu = 2;
    if (per_cu < 1) per_cu = 1;
    grid_blocks = cus * per_cu;
    if (grid_blocks > 512) grid_blocks = 512;
    grid_blocks &= ~7;
  }
  Params P{};
  const float** fp = (const float**)&P;
  (void)fp;
  P.x = (const float*)d_in[0]; P.p = (const float*)d_in[1]; P.pos = (const int*)d_in[2]; P.rel_bias = (const float*)d_in[3];
  P.ev_w_in = (const float*)d_in[4]; P.ev_w_uq = (const float*)d_in[5]; P.ev_w_ukv = (const float*)d_in[6];
  P.ev_q_norm = (const float*)d_in[7]; P.ev_kv_norm = (const float*)d_in[8]; P.lq1 = (const float*)d_in[9];
  P.lk1 = (const float*)d_in[10]; P.lq2 = (const float*)d_in[11]; P.lk2 = (const float*)d_in[12];
  P.ev_subln = (const float*)d_in[13]; P.ev_w_o = (const float*)d_in[14]; P.od_w_in = (const float*)d_in[15];
  P.od_w_o = (const float*)d_in[16]; P.ln1_g = (const float*)d_in[17]; P.ln1_b = (const float*)d_in[18];
  P.ln2_g = (const float*)d_in[19]; P.ln2_b = (const float*)d_in[20]; P.peer_w_q = (const float*)d_in[21];
  P.peer_k1 = (const float*)d_in[22]; P.peer_k2 = (const float*)d_in[23]; P.peer_u = (const float*)d_in[24];
  P.peer_v = (const float*)d_in[25]; P.ple_w = (const float*)d_in[26]; P.ple_gate_w = (const float*)d_in[27];
  P.ple_gate_b = (const float*)d_in[28];
  P.out = (float*)d_out; P.ws = (char*)d_ws;
#if MULTI_LAUNCH
  for (int ph = 0; ph < nph; ++ph) {
    P.ph0 = ph; P.ph1 = ph + 1;
    hipLaunchKernelGGL(megakernel, dim3(grid_blocks), dim3(256), 0, stream, P);
  }
#else
  P.ph0 = 0; P.ph1 = nph;
  hipMemsetAsync((char*)d_ws + OFF_MISC + MS_BAR, 0, XCD_BAR_WORDS * 4, stream);
  void* args[] = {&P};
  hipError_t e = hipLaunchCooperativeKernel((void*)megakernel, dim3(grid_blocks), dim3(256), args, 0, stream);
  if (e != hipSuccess) fprintf(stderr, "cooperative launch failed: %s (grid %d)\n", hipGetErrorString(e), grid_blocks);
#endif
}
```
